# Optimizing an MI355X kernel written in HIP

```python
import math
import jax, jax.numpy as jnp
from jax import lax
import numpy as np

D_MODEL = 1024
BATCH = 2
SEQ = 8192
DEPTH = 2

CHUNK = 64
MEM_LEN = 256
N_MIXERS = 4
GROUP_W = D_MODEL // N_MIXERS
POOL_GROUPS = 4
POOL_CH = GROUP_W // POOL_GROUPS
POOL_WINDOWS = (2, 4, 8, 16)
SCONV_W = 3
DIFF_HEADS = 4
DIFF_DV = GROUP_W // DIFF_HEADS
DIFF_DK = DIFF_DV // 2
ROT_DIMS = DIFF_DK // 4
ROPE_THETA = 500000.0
CONF_W = 31
X_HEADS = 4
X_HD = D_MODEL // X_HEADS
D_FF = ((8 * D_MODEL // 3 + 127) // 128) * 128
Q_BLOCK = 128
EPS = 1e-6

POOL_COLS = GROUP_W
SCONV_COLS = 3 * GROUP_W
DIFF_COLS = 3 * GROUP_W
CONF_COLS = 2 * GROUP_W
IN_COLS = POOL_COLS + SCONV_COLS + DIFF_COLS + CONF_COLS
SPLITS = [POOL_COLS, POOL_COLS + SCONV_COLS, POOL_COLS + SCONV_COLS + DIFF_COLS]

kernel_name = "hybrid_parallel_group_streaming_encoder"


def rms_norm(x, g):
    x32 = x.astype(jnp.float32)
    y = x32 * lax.rsqrt(jnp.mean(x32 * x32, axis=-1, keepdims=True) + EPS)
    return (y * g.astype(jnp.float32)).astype(x.dtype)


def layer_norm(x, g, b):
    x32 = x.astype(jnp.float32)
    mu = jnp.mean(x32, axis=-1, keepdims=True)
    xc = x32 - mu
    y = xc * lax.rsqrt(jnp.mean(xc * xc, axis=-1, keepdims=True) + EPS)
    return (y * g.astype(jnp.float32) + b.astype(jnp.float32)).astype(x.dtype)


def swiglu(h, w_gate, w_up, w_down):
    return (jax.nn.silu(h @ w_gate) * (h @ w_up)) @ w_down


def causal_depthwise_conv(u, w):
    k = w.shape[0]
    return lax.conv_general_dilated(
        u, w[:, None, :].astype(u.dtype), window_strides=(1,), padding=[(k - 1, 0)],
        dimension_numbers=("NWC", "WIO", "NWC"), feature_group_count=u.shape[-1])


def pool_mixer(u, pool_w, pool_scale):
    b, s, _ = u.shape
    ug = u.reshape(b, s, POOL_GROUPS, POOL_CH)
    u32 = ug.astype(jnp.float32)
    cs = jnp.cumsum(u32, axis=1)
    t = jnp.arange(s)
    means = []
    for g, w in enumerate(POOL_WINDOWS):
        c = cs[:, :, g]
        lo = jnp.pad(c, ((0, 0), (w, 0), (0, 0)))[:, :s]
        cnt = jnp.minimum(t + 1, w).astype(jnp.float32)
        means.append((c - lo) / cnt[None, :, None])
    mixed = (jnp.stack(means, axis=2) - u32).astype(u.dtype)
    y = jnp.einsum("bsgc,gcd->bsgd", mixed, pool_w)
    return y.reshape(b, s, GROUP_W) * pool_scale


def partial_rope(x, cos, sin):
    half = ROT_DIMS // 2
    xr = x[..., :ROT_DIMS].astype(jnp.float32)
    x1, x2 = xr[..., :half], xr[..., half:]
    c = cos[:, :, None, None, :]
    s = sin[:, :, None, None, :]
    rot = jnp.concatenate([x1 * c - x2 * s, x2 * c + x1 * s], axis=-1)
    return jnp.concatenate([rot.astype(x.dtype), x[..., ROT_DIMS:]], axis=-1)


def diff_attention(q, k, v, lam):
    b, s = q.shape[:2]
    nb = s // Q_BLOCK
    qb = jnp.moveaxis(q.reshape(b, nb, Q_BLOCK, DIFF_HEADS, 2, DIFF_DK), 1, 0)
    kpos = jnp.arange(s)
    scale = DIFF_DK ** -0.5

    def block(args):
        qblk, i = args
        sc = jnp.einsum("bqhcd,bkhcd->bchqk", qblk, k).astype(jnp.float32) * scale
        qpos = i * Q_BLOCK + jnp.arange(Q_BLOCK)
        limit = (qpos // CHUNK + 1) * CHUNK
        mask = kpos[None, :] < limit[:, None]
        sc = jnp.where(mask, sc, -jnp.inf)
        p = jax.nn.softmax(sc, axis=-1)
        a = p[:, 0] - lam * p[:, 1]
        return jnp.einsum("bhqk,bkhd->bqhd", a.astype(v.dtype), v)

    o = lax.map(block, (qb, jnp.arange(nb)))
    return jnp.moveaxis(o, 0, 1).reshape(b, s, DIFF_HEADS, DIFF_DV)


def setup_inputs(seed: int = 0) -> dict:
    key = jax.random.key(seed)
    ks = iter(jax.random.split(key, 64))

    def nrm(shape, scale):
        return scale * jax.random.normal(next(ks), shape, jnp.float32)

    def gain(shape):
        return 1.0 + nrm(shape, 0.02)

    L, D, F, G = DEPTH, D_MODEL, D_FF, GROUP_W
    return {
        "x": nrm((BATCH, SEQ, D), 1.0),
        "mem": nrm((BATCH, MEM_LEN, D), 1.0),
        "positions": jnp.broadcast_to(jnp.arange(SEQ, dtype=jnp.int32), (BATCH, SEQ)),
        "f1_pre_g": gain((L, D)),
        "f1_w_gate": nrm((L, D, F), D ** -0.5),
        "f1_w_up": nrm((L, D, F), D ** -0.5),
        "f1_w_down": nrm((L, F, D), F ** -0.5),
        "f1_post_g": gain((L, D)),
        "mix_pre_g": gain((L, D)),
        "w_in": nrm((L, D, IN_COLS), D ** -0.5),
        "pool_w": nrm((L, POOL_GROUPS, POOL_CH, POOL_CH), POOL_CH ** -0.5),
        "pool_scale": gain((L, G)),
        "sconv_w": nrm((L, SCONV_W, G), SCONV_W ** -0.5),
        "lam_q1": nrm((L, DIFF_DK), 0.1),
        "lam_k1": nrm((L, DIFF_DK), 0.1),
        "lam_q2": nrm((L, DIFF_DK), 0.1),
        "lam_k2": nrm((L, DIFF_DK), 0.1),
        "diff_subln_g": gain((L, DIFF_DV)),
        "conf_dw_w": nrm((L, CONF_W, G), CONF_W ** -0.5),
        "conf_dw_b": nrm((L, G), 0.02),
        "conf_ln_g": gain((L, G)),
        "conf_ln_b": nrm((L, G), 0.02),
        "w_o": nrm((L, D, D), D ** -0.5),
        "mix_post_g": gain((L, D)),
        "x_pre_g": gain((L, D)),
        "x_mem_g": gain((L, D)),
        "x_wq": nrm((L, D, D), D ** -0.5),
        "x_wk": nrm((L, D, D), D ** -0.5),
        "x_wv": nrm((L, D, D), D ** -0.5),
        "x_wo": nrm((L, D, D), D ** -0.5),
        "x_post_g": gain((L, D)),
        "f2_pre_g": gain((L, D)),
        "f2_w_gate": nrm((L, D, F), D ** -0.5),
        "f2_w_up": nrm((L, D, F), D ** -0.5),
        "f2_w_down": nrm((L, F, D), F ** -0.5),
        "f2_post_g": gain((L, D)),
    }


def reference(x, mem, positions,
              f1_pre_g, f1_w_gate, f1_w_up, f1_w_down, f1_post_g,
              mix_pre_g, w_in, pool_w, pool_scale, sconv_w,
              lam_q1, lam_k1, lam_q2, lam_k2, diff_subln_g,
              conf_dw_w, conf_dw_b, conf_ln_g, conf_ln_b, w_o, mix_post_g,
              x_pre_g, x_mem_g, x_wq, x_wk, x_wv, x_wo, x_post_g,
              f2_pre_g, f2_w_gate, f2_w_up, f2_w_down, f2_post_g):
    b, s, d = x.shape
    m_len = mem.shape[1]
    inv_freq = ROPE_THETA ** (-jnp.arange(0, ROT_DIMS, 2, dtype=jnp.float32) / ROT_DIMS)
    ang = positions.astype(jnp.float32)[..., None] * inv_freq
    cos, sin = jnp.cos(ang), jnp.sin(ang)

    for l in range(DEPTH):
        h = rms_norm(x, f1_pre_g[l])
        x = x + 0.5 * rms_norm(swiglu(h, f1_w_gate[l], f1_w_up[l], f1_w_down[l]), f1_post_g[l])

        h = rms_norm(x, mix_pre_g[l])
        z = h @ w_in[l]
        za, zb, zc, zd = jnp.split(z, SPLITS, axis=-1)

        ya = pool_mixer(za, pool_w[l], pool_scale[l])

        xs, bg, cg = jnp.split(zb, 3, axis=-1)
        yb = bg * causal_depthwise_conv(cg * xs, sconv_w[l])

        zq, zk, zv = jnp.split(zc, 3, axis=-1)
        q = partial_rope(zq.reshape(b, s, DIFF_HEADS, 2, DIFF_DK), cos, sin)
        k = partial_rope(zk.reshape(b, s, DIFF_HEADS, 2, DIFF_DK), cos, sin)
        v = zv.reshape(b, s, DIFF_HEADS, DIFF_DV)
        lambda_init = 0.8 - 0.6 * math.exp(-0.3 * l)
        lam = (jnp.exp(jnp.sum(lam_q1[l].astype(jnp.float32) * lam_k1[l].astype(jnp.float32)))
               - jnp.exp(jnp.sum(lam_q2[l].astype(jnp.float32) * lam_k2[l].astype(jnp.float32)))
               + lambda_init)
        o = diff_attention(q, k, v, lam)
        yc = (rms_norm(o, diff_subln_g[l]) * (1.0 - lambda_init)).reshape(b, s, GROUP_W)

        ga, gg = jnp.split(zd, 2, axis=-1)
        u = ga * jax.nn.sigmoid(gg)
        u = causal_depthwise_conv(u, conf_dw_w[l]) + conf_dw_b[l]
        yd = jax.nn.silu(layer_norm(u, conf_ln_g[l], conf_ln_b[l]))

        y = jnp.concatenate([ya, yb, yc, yd], axis=-1) @ w_o[l]
        x = x + rms_norm(y, mix_post_g[l])

        h = rms_norm(x, x_pre_g[l])
        mn = rms_norm(mem, x_mem_g[l])
        qx = (h @ x_wq[l]).reshape(b, s, X_HEADS, X_HD)
        kx = (mn @ x_wk[l]).reshape(b, m_len, X_HEADS, X_HD)
        vx = (mn @ x_wv[l]).reshape(b, m_len, X_HEADS, X_HD)
        sc = jnp.einsum("bshd,bmhd->bhsm", qx, kx).astype(jnp.float32) * (X_HD ** -0.5)
        p = jax.nn.softmax(sc, axis=-1)
        ox = jnp.einsum("bhsm,bmhd->bshd", p.astype(vx.dtype), vx).reshape(b, s, d) @ x_wo[l]
        x = x + rms_norm(ox, x_post_g[l])

        h = rms_norm(x, f2_pre_g[l])
        x = x + 0.5 * rms_norm(swiglu(h, f2_w_gate[l], f2_w_up[l], f2_w_down[l]), f2_post_g[l])
    return x
```

```cpp
#include <hip/hip_runtime.h>
#include <hip/hip_cooperative_groups.h>
#include <cstdio>
#include <cstdint>
#include <cmath>
namespace cg = cooperative_groups;

#define LAS __attribute__((address_space(3)))
typedef unsigned short bf16_t;
typedef short bf16x8 __attribute__((ext_vector_type(8)));
typedef float f32x4 __attribute__((ext_vector_type(4)));
typedef float f32x16 __attribute__((ext_vector_type(16)));
typedef unsigned u32x4 __attribute__((ext_vector_type(4)));
typedef unsigned u32x2 __attribute__((ext_vector_type(2)));

#ifndef USE_CG_SYNC
#define USE_CG_SYNC 1
#endif

constexpr int NTOK = 16384, DM = 1024, FF = 2816, SEQ = 8192, ZLD = 2048;
constexpr float EPS = 1e-6f;
constexpr size_t LW = 24903680;
constexpr size_t OW_GU1 = 0, OW_D1 = 5767168, OW_GU2 = 8650752, OW_D2 = 14417920, OW_IN = 17301504, OW_O = 19660800,
                 OW_Q = 20709376, OW_K = 21757952, OW_V = 22806528, OW_XO = 23855104;
constexpr size_t WS_W = 0, WS_XN = 99614720, WS_BIG = 133169152, WS_Y = 225443840, WS_KV = 258998272, WS_CTL = 263192576, WS_END = 263192576 + 131072 + 524288 + 262144;
constexpr int LDS_BYTES = 147456;
constexpr int ITEMS_PER_LAYER = 6080;

struct Params {
    const float* in[36];
    float* out;
    unsigned char* ws;
};

__device__ __forceinline__ unsigned cvt_pk_bf16(float lo, float hi) { unsigned r; asm volatile("v_cvt_pk_bf16_f32 %0, %1, %2" : "=v"(r) : "v"(lo), "v"(hi)); return r; }
typedef float f32x2_t __attribute__((ext_vector_type(2))); typedef __bf16 bf16x2_t __attribute__((ext_vector_type(2)));
__device__ __forceinline__ unsigned cvtpk_s(float lo, float hi) { f32x2_t v = {lo, hi}; bf16x2_t b = __builtin_convertvector(v, bf16x2_t); return __builtin_bit_cast(unsigned, b); }
__device__ __forceinline__ int lane_id() { int l; asm volatile("v_mbcnt_lo_u32_b32 %0, -1, 0\n\tv_mbcnt_hi_u32_b32 %0, -1, %0" : "=v"(l)); return l; }
__device__ __forceinline__ float bf_lo(unsigned w) { return __uint_as_float(w << 16); }
__device__ __forceinline__ float bf_hi(unsigned w) { return __uint_as_float(w & 0xffff0000u); }
__device__ __forceinline__ float bf2f(bf16_t h) { return __uint_as_float(((unsigned)h) << 16); }
template <int M> __device__ __forceinline__ float shx(float v) {
    static_assert(M < 32, "use sum32 / max32 for the half-wave exchange");
    return __uint_as_float((unsigned)__builtin_amdgcn_ds_swizzle((int)__float_as_uint(v), (M << 10) | 0x1f));
}
__device__ __forceinline__ float sum32(float v) { auto rr = __builtin_amdgcn_permlane32_swap(__float_as_uint(v), __float_as_uint(v), false, false); return __uint_as_float(rr[0]) + __uint_as_float(rr[1]); }
__device__ __forceinline__ float max32(float v) { auto rr = __builtin_amdgcn_permlane32_swap(__float_as_uint(v), __float_as_uint(v), false, false); return fmaxf(__uint_as_float(rr[0]), __uint_as_float(rr[1])); }
__device__ __forceinline__ float wave_sum(float v) {
    v += shx<1>(v); v += shx<2>(v); v += shx<4>(v); v += shx<8>(v); v += shx<16>(v);
    { auto rr = __builtin_amdgcn_permlane32_swap(__float_as_uint(v), __float_as_uint(v), false, false); v = __uint_as_float(rr[0]) + __uint_as_float(rr[1]); }
    return v;
}
__device__ __forceinline__ float fast_exp2(float x) { return __builtin_amdgcn_exp2f(x); }
__device__ __forceinline__ float fast_rcp(float x) { return __builtin_amdgcn_rcpf(x); }
__device__ __forceinline__ float sigmoidf_(float x) { return fast_rcp(1.0f + fast_exp2(-1.4426950408889634f * x)); }
__device__ __forceinline__ void ld8(const bf16_t* p, float (&f)[8]) {
    const u32x4 w = *(const u32x4*)p;
    f[0] = bf_lo(w.x); f[1] = bf_hi(w.x); f[2] = bf_lo(w.y); f[3] = bf_hi(w.y); f[4] = bf_lo(w.z); f[5] = bf_hi(w.z); f[6] = bf_lo(w.w); f[7] = bf_hi(w.w);
}

__device__ __forceinline__ const float* ld_ptr(volatile LAS unsigned long long* tab, int k) {
    const unsigned long long v = tab[k];
    const unsigned lo = __builtin_amdgcn_readfirstlane((unsigned)v), hi = __builtin_amdgcn_readfirstlane((unsigned)(v >> 32));
    return (const float*)(((unsigned long long)hi << 32) | lo);
}

namespace pg8 {
constexpr int BM = 256, BK = 64, HALF = 128, HTB = HALF * BK * 2, STAGE_BYTES = 8 * HTB, NXCD = 8, WGM = 8;
__host__ __device__ __forceinline__ int lds_byte(int r, int c) { const int st = (r >> 4) * 2 + (c >> 5), rr = r & 15, cc = c & 31, ob = rr * 64 + cc * 2; return st * 1024 + (ob ^ (((ob >> 9) & 1) << 5)); }
__host__ __device__ __forceinline__ void stage_rc(int b, int& R, int& C) { const int st = b / 1024, sb = b % 1024, swz = sb ^ (((sb >> 9) & 1) << 5); R = (st >> 1) * 16 + swz / 64; C = (st & 1) * 32 + (swz % 64) / 2; }
__host__ __device__ __forceinline__ int perm32(int rho) { const int n = rho >> 4, i = rho & 15; return 8 * (i >> 2) + 4 * n + (i & 3); }

struct Unit { int pm, pn; };
struct Gemm { const bf16_t* A; const bf16_t* Bt; int M, N, K, lda, ldb; long a_pm, a_pn, b_pn, b_pb; int bshift; };
__device__ __forceinline__ Gemm make_gemm(const bf16_t* A, const bf16_t* Bt, int M, int N, int K, int lda, int ldb) {
    Gemm g; g.A = A; g.Bt = Bt; g.M = M; g.N = N; g.K = K; g.lda = lda; g.ldb = ldb; g.a_pm = (long)BM * lda; g.a_pn = 0; g.b_pn = (long)BM * ldb; g.b_pb = 0; g.bshift = 0; return g;
}

struct StaticOrder {
    int nM, nN, nwg, G, c;
    __device__ void init(int M, int N, int G_, int c_) { nM = M / BM; nN = N / BM; nwg = nM * nN; G = G_; c = c_; }
    __device__ bool next(int i, Unit& u) const {
        const long L = (long)i * G + c; if (L >= nwg) return false;
        int wgid = (int)L; { const int q = nwg / NXCD, r = nwg % NXCD, xcd = wgid % NXCD, off = wgid / NXCD; wgid = (xcd < r ? xcd * (q + 1) : r * (q + 1) + (xcd - r) * q) + off; }
        const int nig = WGM * nN, gid = wgid / nig, fm = gid * WGM, gsz = (nM - fm) < WGM ? (nM - fm) : WGM;
        u.pm = fm + ((wgid % nig) % gsz); u.pn = (wgid % nig) / gsz; return true;
    }
};

__device__ __forceinline__ float rstd_of(const float* pss, int row) { const f32x4 p = *(const f32x4*)(pss + 4 * (size_t)row); return __builtin_amdgcn_rsqf(((p.x + p.y) + (p.z + p.w)) * (1.0f / 1024.0f) + EPS); }
__device__ __forceinline__ float pss_lane(const float* pss, int row, int fq) { return pss[4 * (size_t)row + fq]; }
__device__ __forceinline__ float rstd_fin(float v) { v += shx<16>(v); v = sum32(v); return __builtin_amdgcn_rsqf(v * (1.0f / 1024.0f) + EPS); }
template <int K> __device__ __forceinline__ float bcast16(float v) {
    return __uint_as_float((unsigned)__builtin_amdgcn_ds_swizzle((int)__float_as_uint(v), 0x10 | (K << 5)));
}
template <bool HAS_CS> struct EpiOutT {
    static constexpr bool PERM = true, AFTER_DRAIN = false;
    bf16_t* O; int ldc; float sc; const float* rs; const float* cs;
    __device__ __forceinline__ void operator()(const f32x4 (&acc)[2][2][4][2], const Unit& u, int wr, int wc, int fr, int fq) const {
        const int row0 = u.pm * BM + wr * 64 + fr; const int col0 = u.pn * BM + wc * 32 + 8 * fq;
        f32x4 cv[2][2];
        if constexpr (HAS_CS) {
            const float r = rstd_of(cs, col0 + (fr >> 3) * HALF + (fr & 7));
            cv[0][0] = (f32x4){bcast16<0>(r), bcast16<1>(r), bcast16<2>(r), bcast16<3>(r)};   cv[0][1] = (f32x4){bcast16<4>(r), bcast16<5>(r), bcast16<6>(r), bcast16<7>(r)};
            cv[1][0] = (f32x4){bcast16<8>(r), bcast16<9>(r), bcast16<10>(r), bcast16<11>(r)}; cv[1][1] = (f32x4){bcast16<12>(r), bcast16<13>(r), bcast16<14>(r), bcast16<15>(r)};
        } else {
#pragma unroll
            for (int bj = 0; bj < 2; ++bj)
#pragma unroll
                for (int n = 0; n < 2; ++n) cv[bj][n] = (f32x4){1.f, 1.f, 1.f, 1.f};
        }
        float rsv[2][4];
#pragma unroll
        for (int ai = 0; ai < 2; ++ai)
#pragma unroll
            for (int m = 0; m < 4; ++m) rsv[ai][m] = rs ? pss_lane(rs, row0 + ai * HALF + m * 16, fq) : 0.f;
        if (rs) {
#pragma unroll
            for (int ai = 0; ai < 2; ++ai)
#pragma unroll
                for (int m = 0; m < 4; ++m) rsv[ai][m] = rstd_fin(rsv[ai][m]);
        } else {
#pragma unroll
            for (int ai = 0; ai < 2; ++ai)
#pragma unroll
                for (int m = 0; m < 4; ++m) rsv[ai][m] = 1.0f;
        }
#pragma unroll
        for (int ai = 0; ai < 2; ++ai)
#pragma unroll
            for (int m = 0; m < 4; ++m) { bf16_t* rowp = O + (size_t)(row0 + ai * HALF + m * 16) * ldc + col0;
                const float rsc = rsv[ai][m];
#pragma unroll
                for (int bj = 0; bj < 2; ++bj) { f32x4 v0, v1;
                    if constexpr (HAS_CS) { v0 = acc[ai][bj][m][0] * cv[bj][0] * rsc; v1 = acc[ai][bj][m][1] * cv[bj][1] * rsc; }
                    else { const float s_ = sc * rsc; v0 = acc[ai][bj][m][0] * s_; v1 = acc[ai][bj][m][1] * s_; }
                    u32x4 w; w.x = cvt_pk_bf16(v0[0], v0[1]); w.y = cvt_pk_bf16(v0[2], v0[3]); w.z = cvt_pk_bf16(v1[0], v1[1]); w.w = cvt_pk_bf16(v1[2], v1[3]);
                    *(u32x4*)(rowp + bj * HALF) = w; } }
    }
};
typedef EpiOutT<false> EpiOut; typedef EpiOutT<true> EpiOutCS;
struct EpiSwiGLU {
    static constexpr bool PERM = true, AFTER_DRAIN = false;
    bf16_t* O; int ldc; const float* rs;
    __device__ __forceinline__ void operator()(const f32x4 (&acc)[2][2][4][2], const Unit& u, int wr, int wc, int fr, int fq) const {
        const int row0 = u.pm * BM + wr * 64 + fr; const int col0 = u.pn * HALF + wc * 32 + 8 * fq;
        float rsv[2][4];
#pragma unroll
        for (int ai = 0; ai < 2; ++ai)
#pragma unroll
            for (int m = 0; m < 4; ++m) rsv[ai][m] = pss_lane(rs, row0 + ai * HALF + m * 16, fq);
#pragma unroll
        for (int ai = 0; ai < 2; ++ai)
#pragma unroll
            for (int m = 0; m < 4; ++m) rsv[ai][m] = rstd_fin(rsv[ai][m]);
#pragma unroll
        for (int ai = 0; ai < 2; ++ai)
#pragma unroll
            for (int m = 0; m < 4; ++m) { bf16_t* rowp = O + (size_t)(row0 + ai * HALF + m * 16) * ldc + col0;
                const float rsc = rsv[ai][m];
                float h[8], gg[8], uu[8], ee[8];
#pragma unroll
                for (int q = 0; q < 8; ++q) { gg[q] = acc[ai][0][m][q >> 2][q & 3] * rsc; uu[q] = acc[ai][1][m][q >> 2][q & 3] * rsc; }
#pragma unroll
                for (int q = 0; q < 8; ++q) ee[q] = fast_exp2(-1.4426950408889634f * gg[q]);
#pragma unroll
                for (int q = 0; q < 8; ++q) uu[q] *= gg[q];
#pragma unroll
                for (int q = 0; q < 8; ++q) ee[q] = fast_rcp(1.0f + ee[q]);
#pragma unroll
                for (int q = 0; q < 8; ++q) h[q] = uu[q] * ee[q];
                u32x4 w; w.x = cvt_pk_bf16(h[0], h[1]); w.y = cvt_pk_bf16(h[2], h[3]); w.z = cvt_pk_bf16(h[4], h[5]); w.w = cvt_pk_bf16(h[6], h[7]);
                *(u32x4*)rowp = w; }
    }
};
struct EpiWin {
    static constexpr bool PERM = true, AFTER_DRAIN = false;
    bf16_t* O; int ldc; const int* pos; float qscale; const float* rs; bf16_t* QC;
    __device__ __forceinline__ void operator()(f32x4 (&acc)[2][2][4][2], const Unit& u, int wr, int wc, int fr, int fq) const {
        const int row0 = u.pm * BM + wr * 64 + fr; const int col0 = u.pn * BM + wc * 32 + 8 * fq;
        const bool rope = (u.pn == 4 || u.pn == 5);
        const float sc = (u.pn == 4) ? qscale : 1.0f;
        float rsv[2][4];
#pragma unroll
        for (int ai = 0; ai < 2; ++ai)
#pragma unroll
            for (int m = 0; m < 4; ++m) rsv[ai][m] = pss_lane(rs, row0 + ai * HALF + m * 16, fq);
#pragma unroll
        for (int ai = 0; ai < 2; ++ai)
#pragma unroll
            for (int m = 0; m < 4; ++m) rsv[ai][m] = sc * rstd_fin(rsv[ai][m]);
        if (rope && fq == 0) {
            int posv[2][4];
#pragma unroll
            for (int ai = 0; ai < 2; ++ai)
#pragma unroll
                for (int m = 0; m < 4; ++m) posv[ai][m] = pos[row0 + ai * HALF + m * 16];
#pragma unroll
            for (int ai = 0; ai < 2; ++ai)
#pragma unroll
                for (int m = 0; m < 4; ++m) {
                    const float p = (float)posv[ai][m];
                    const float invf[4] = {1.0f, 0.03760603093086394f, 0.0014142135623730951f, 5.318295896944989e-05f};
                    float cs[4], sn[4];
#pragma unroll
                    for (int i = 0; i < 4; ++i) { const float ang = p * invf[i];
                        const float fr_ = __builtin_amdgcn_fractf(ang * 0.15915494309189535f);
                        sn[i] = __builtin_amdgcn_sinf(fr_); cs[i] = __builtin_amdgcn_cosf(fr_); }
#pragma unroll
                    for (int bj = 0; bj < 2; ++bj) { const f32x4 x1 = acc[ai][bj][m][0], x2 = acc[ai][bj][m][1];
#pragma unroll
                        for (int i = 0; i < 4; ++i) { acc[ai][bj][m][0][i] = x1[i] * cs[i] - x2[i] * sn[i]; acc[ai][bj][m][1][i] = x2[i] * cs[i] + x1[i] * sn[i]; } }
                }
        }
#pragma unroll
        for (int ai = 0; ai < 2; ++ai)
#pragma unroll
            for (int m = 0; m < 4; ++m) { const int row = row0 + ai * HALF + m * 16; bf16_t* rowp = O + (size_t)row * ldc + col0;
                const float rsc = rsv[ai][m];
                bf16_t* cp = QC + (rope ? (size_t)(u.pn - 4) * 8 * 8192 * 64 : 0) + ((size_t)((row >> 13) * 4 + (wc >> 1)) * 8192 + (row & 8191)) * 64 + (wc & 1) * 32 + 8 * fq;
#pragma unroll
                for (int bj = 0; bj < 2; ++bj) { const f32x4 v0 = acc[ai][bj][m][0] * rsc, v1 = acc[ai][bj][m][1] * rsc;
                    u32x4 w; w.x = cvt_pk_bf16(v0[0], v0[1]); w.y = cvt_pk_bf16(v0[2], v0[3]); w.z = cvt_pk_bf16(v1[0], v1[1]); w.w = cvt_pk_bf16(v1[2], v1[3]);
                    if (rope) *(u32x4*)(cp + (size_t)bj * 2 * 8192 * 64) = w; else *(u32x4*)(rowp + bj * HALF) = w; } }
    }
};
struct EpiSoftmax {
    static constexpr bool PERM = true, AFTER_DRAIN = true;
    bf16_t* O; int ldc;
    __device__ __forceinline__ void fused(f32x4 (&acc)[2][2][4][2], const Unit& u, int wr, int wc, int fr, int fq, LAS unsigned char* lds, int wid, int lane) const {
        LAS float* Pm = (LAS float*)lds; LAS float* Ps = (LAS float*)(lds + 4096);
#pragma unroll
        for (int ai = 0; ai < 2; ++ai)
#pragma unroll
            for (int m = 0; m < 4; ++m) { float v = -INFINITY;
#pragma unroll
                for (int bj = 0; bj < 2; ++bj)
#pragma unroll
                    for (int n = 0; n < 2; ++n) { const f32x4 x = acc[ai][bj][m][n]; v = fmaxf(v, fmaxf(fmaxf(x[0], x[1]), fmaxf(x[2], x[3]))); }
                v = fmaxf(v, shx<16>(v)); v = max32(v);
                if (fq == 0) Pm[(ai * HALF + wr * 64 + m * 16 + fr) * 4 + wc] = v; }
        __syncthreads();
#pragma unroll
        for (int ai = 0; ai < 2; ++ai)
#pragma unroll
            for (int m = 0; m < 4; ++m) { const int row = ai * HALF + wr * 64 + m * 16 + fr; const f32x4 t = *(const LAS f32x4*)(Pm + row * 4);
                const float mx = fmaxf(fmaxf(t[0], t[1]), fmaxf(t[2], t[3])); float s = 0.f;
#pragma unroll
                for (int bj = 0; bj < 2; ++bj)
#pragma unroll
                    for (int n = 0; n < 2; ++n)
#pragma unroll
                        for (int j = 0; j < 4; ++j) acc[ai][bj][m][n][j] = fast_exp2(acc[ai][bj][m][n][j] - mx);
#pragma unroll
                for (int bj = 0; bj < 2; ++bj)
#pragma unroll
                    for (int n = 0; n < 2; ++n) { const f32x4 x = acc[ai][bj][m][n]; s += (x[0] + x[1]) + (x[2] + x[3]); }
                {
                s += shx<16>(s); s = sum32(s);
                if (fq == 0) Ps[row * 4 + wc] = s; } }
        __syncthreads();
        const int col0 = u.pn * BM + wc * 32 + 8 * fq;
#pragma unroll
        for (int ai = 0; ai < 2; ++ai)
#pragma unroll
            for (int m = 0; m < 4; ++m) { const int row = ai * HALF + wr * 64 + m * 16 + fr; const f32x4 t = *(const LAS f32x4*)(Ps + row * 4);
                const float inv = 1.0f / ((t[0] + t[1]) + (t[2] + t[3]));
                bf16_t* rowp = O + (size_t)(u.pm * BM + row) * ldc + col0;
#pragma unroll
                for (int bj = 0; bj < 2; ++bj) { const f32x4 v0 = acc[ai][bj][m][0] * inv, v1 = acc[ai][bj][m][1] * inv;
                    u32x4 w; w.x = cvt_pk_bf16(v0[0], v0[1]); w.y = cvt_pk_bf16(v0[2], v0[3]); w.z = cvt_pk_bf16(v1[0], v1[1]); w.w = cvt_pk_bf16(v1[2], v1[3]);
                    *(u32x4*)(rowp + bj * HALF) = w; } }
        __syncthreads();
    }
};


__device__ __forceinline__ void panel_exchange(const float (&part)[2][4], float* slotbuf, unsigned* cntw, unsigned want, int pm, int pn, int wr, int wc, int fr, int fq, LAS unsigned char* lds, int wid, int lane) {
    LAS float* P = (LAS float*)lds; LAS float* S = (LAS float*)(lds + 8192);
    if (fq == 0) {
#pragma unroll
        for (int ai = 0; ai < 2; ++ai)
#pragma unroll
            for (int m = 0; m < 4; ++m) P[(ai * HALF + wr * 64 + m * 16 + fr) * 4 + wc] = part[ai][m];
    }
    __syncthreads();
    const int tid = wid * 64 + lane;
    if (tid < 256) { const f32x4 t = *(const LAS f32x4*)(P + tid * 4);
        __hip_atomic_store(slotbuf + ((size_t)(pm * BM + tid)) * 4 + pn, (t.x + t.y) + (t.z + t.w), __ATOMIC_RELAXED, __HIP_MEMORY_SCOPE_AGENT); }
    asm volatile("s_waitcnt vmcnt(0)" ::: "memory");
    if (wid < 4 && lane == 0) __hip_atomic_fetch_add(cntw, 1u, __ATOMIC_RELAXED, __HIP_MEMORY_SCOPE_AGENT);
    if (wid == 0) {
        unsigned sp = 0;
        while ((unsigned)__builtin_amdgcn_readfirstlane(__hip_atomic_load(cntw, __ATOMIC_RELAXED, __HIP_MEMORY_SCOPE_AGENT)) < want) { __builtin_amdgcn_s_sleep(2); if (++sp > (1u << 22)) break; }
        __builtin_amdgcn_fence(__ATOMIC_ACQUIRE, "agent");
    }
    asm volatile("s_waitcnt vmcnt(0) lgkmcnt(0)" ::: "memory"); __syncthreads();
    if (tid < 256) { const float* sl = slotbuf + ((size_t)(pm * BM + tid)) * 4;
        f32x4 q; asm volatile("global_load_dwordx4 %0, %1, off sc1\n\ts_waitcnt vmcnt(0)" : "=&v"(q) : "v"(sl) : "memory");
        S[tid] = (q.x + q.y) + (q.z + q.w); }
    __syncthreads();
}
template <bool FINAL> struct EpiRes {
    static constexpr bool PERM = true, AFTER_DRAIN = true;
    bf16_t* XB; const float* gpost; float wgt; float* rstd; float* outf; float* slots; unsigned* cnt; unsigned xk;
    __device__ __forceinline__ void fused(f32x4 (&acc)[2][2][4][2], const Unit& u, int wr, int wc, int fr, int fq, LAS unsigned char* lds, int wid, int lane) const {
        const LAS float* S = (const LAS float*)(lds + 8192);
        const int col0 = u.pn * BM + wc * 32 + 8 * fq;
        u32x4 xres[2][4][2]; f32x4 gv[2][2];
#pragma unroll
        for (int ai = 0; ai < 2; ++ai)
#pragma unroll
            for (int m = 0; m < 4; ++m)
#pragma unroll
                for (int bj = 0; bj < 2; ++bj) xres[ai][m][bj] = *(const u32x4*)(XB + (size_t)(u.pm * BM + ai * HALF + wr * 64 + m * 16 + fr) * 1024 + col0 + bj * HALF);
#pragma unroll
        for (int bj = 0; bj < 2; ++bj)
#pragma unroll
            for (int n = 0; n < 2; ++n) gv[bj][n] = *(const f32x4*)(gpost + col0 + bj * HALF + 4 * n);
        float part[2][4];
#pragma unroll
        for (int ai = 0; ai < 2; ++ai)
#pragma unroll
            for (int m = 0; m < 4; ++m) { float s = 0.f;
#pragma unroll
                for (int bj = 0; bj < 2; ++bj)
#pragma unroll
                    for (int n = 0; n < 2; ++n) { const f32x4 x = acc[ai][bj][m][n]; s += (x[0] * x[0] + x[1] * x[1]) + (x[2] * x[2] + x[3] * x[3]); }
                s += shx<16>(s); s = sum32(s); part[ai][m] = s; }
        panel_exchange(part, slots + (size_t)(xk & 1u) * 65536, cnt + 64 * u.pm, 16u * (xk + 1u), u.pm, u.pn, wr, wc, fr, fq, lds, wid, lane);
#pragma unroll
        for (int ai = 0; ai < 2; ++ai)
#pragma unroll
            for (int m = 0; m < 4; ++m) { const int row = ai * HALF + wr * 64 + m * 16 + fr; const float rs = wgt * __builtin_amdgcn_rsqf(S[row] * (1.0f / 1024.0f) + EPS);
                bf16_t* xp = XB + (size_t)(u.pm * BM + row) * 1024 + col0; float s2 = 0.f;
#pragma unroll
                for (int bj = 0; bj < 2; ++bj) { const u32x4 xw = xres[ai][m][bj];
                    const f32x4 x0 = (f32x4){bf_lo(xw.x), bf_hi(xw.x), bf_lo(xw.y), bf_hi(xw.y)}, x1 = (f32x4){bf_lo(xw.z), bf_hi(xw.z), bf_lo(xw.w), bf_hi(xw.w)};
                    const f32x4 v0 = x0 + acc[ai][bj][m][0] * gv[bj][0] * rs, v1 = x1 + acc[ai][bj][m][1] * gv[bj][1] * rs;
                    if constexpr (FINAL) { float* op = outf + (size_t)(u.pm * BM + row) * 1024 + col0 + bj * HALF; *(f32x4*)op = v0; *(f32x4*)(op + 4) = v1; }
                    else { u32x4 w; w.x = cvt_pk_bf16(v0[0], v0[1]); w.y = cvt_pk_bf16(v0[2], v0[3]); w.z = cvt_pk_bf16(v1[0], v1[1]); w.w = cvt_pk_bf16(v1[2], v1[3]);
                        *(u32x4*)(xp + bj * HALF) = w;
                        const float a0 = bf_lo(w.x), a1 = bf_hi(w.x), a2 = bf_lo(w.y), a3 = bf_hi(w.y), a4 = bf_lo(w.z), a5 = bf_hi(w.z), a6 = bf_lo(w.w), a7 = bf_hi(w.w);
                        s2 += ((a0 * a0 + a1 * a1) + (a2 * a2 + a3 * a3)) + ((a4 * a4 + a5 * a5) + (a6 * a6 + a7 * a7)); } }
                if constexpr (!FINAL) { s2 += shx<16>(s2); s2 = sum32(s2); part[ai][m] = s2; } }
        if constexpr (!FINAL) {
            LAS float* P = (LAS float*)lds;
            if (fq == 0) {
#pragma unroll
                for (int ai = 0; ai < 2; ++ai)
#pragma unroll
                    for (int m = 0; m < 4; ++m) P[(ai * HALF + wr * 64 + m * 16 + fr) * 4 + wc] = part[ai][m];
            }
            __syncthreads();
            const int tid = wid * 64 + lane;
            if (tid < 256) { const f32x4 t = *(const LAS f32x4*)(P + tid * 4); rstd[((size_t)(u.pm * BM + tid)) * 4 + u.pn] = (t.x + t.y) + (t.z + t.w); }
            __syncthreads();
        }
    }
};

template <class Epi, class Sched, bool ALIGN_EPI = false, bool SP2 = false>
__device__ __forceinline__ void gemm_phase(LAS unsigned char* lds, const Gemm g, const Sched S, const Epi E, int wid0) {
    int tid = wid0 * 64 + lane_id(); asm volatile("" : "+v"(tid));
    const int wid = __builtin_amdgcn_readfirstlane(tid >> 6), lane = tid & 63, wr = wid >> 2, wc = wid & 3, fr = lane & 15, fq = lane >> 4;
    const int K = g.K, nt = K / BK;
    unsigned voffA[2], voffB[2];
#pragma unroll
    for (int i = 0; i < 2; ++i) { int R, C; stage_rc(tid * 16 + i * 8192, R, C); const int Rb = Epi::PERM ? ((R & ~31) + perm32(R & 31)) : R;
        voffA[i] = (unsigned)(R * g.lda + C) * 2u; voffB[i] = (unsigned)(Rb * g.ldb + C) * 2u; }
    const size_t kstep = (size_t)(BK * 2);
    const size_t hstepA = (size_t)HALF * g.lda * 2, hstepB = (size_t)HALF * g.ldb * 2;
    const unsigned ldsw = (unsigned)wid * 1024u;
    const int aoff = lds_byte(wr * 64 + fr, fq * 8), boff = lds_byte(wc * 32 + fr, fq * 8);
#define PG8_UA(u) ((const char*)g.A + 2 * ((long)(u).pm * g.a_pm + (long)(u).pn * g.a_pn))
#define PG8_UB(u) ((const char*)g.Bt + 2 * ((long)(u).pn * g.b_pn + (long)((u).pm >> g.bshift) * g.b_pb))
#define PG8_SA(b, h) (((b) * 2 + (h)) * HTB)
#define PG8_SB(b, h) ((4 + (b) * 2 + (h)) * HTB)
#define PG8_STAGE(bufoff, gbase, voff) do { _Pragma("unroll") for (int _i = 0; _i < 2; ++_i) \
        __builtin_amdgcn_global_load_lds((const unsigned*)((const char*)(gbase) + (voff)[_i]), (LAS unsigned*)(lds + (bufoff) + ldsw + _i * 8192), 16, 0, 0); } while (0)
#define PG8_LDA(dst, b, h) do { _Pragma("unroll") for (int m = 0; m < 4; ++m) _Pragma("unroll") for (int k = 0; k < 2; ++k) dst[m][k] = *(const LAS bf16x8*)(lds + PG8_SA(b, h) + aoff + m * 2048 + k * 1024); } while (0)
#define PG8_LDB(dst, b, h) do { _Pragma("unroll") for (int n = 0; n < 2; ++n) _Pragma("unroll") for (int k = 0; k < 2; ++k) dst[n][k] = *(const LAS bf16x8*)(lds + PG8_SB(b, h) + boff + n * 2048 + k * 1024); } while (0)
#define PG8_MMA(ai, bj, At, Bt) do { __builtin_amdgcn_s_setprio(1); _Pragma("unroll") for (int m = 0; m < 4; ++m) _Pragma("unroll") for (int n = 0; n < 2; ++n) _Pragma("unroll") for (int k = 0; k < 2; ++k) \
        acc[ai][bj][m][n] = __builtin_amdgcn_mfma_f32_16x16x32_bf16(Bt[n][k], At[m][k], acc[ai][bj][m][n], 0, 0, 0); __builtin_amdgcn_s_setprio(0); } while (0)
#define PG8_WAIT_V(n) asm volatile("s_waitcnt vmcnt(" #n ")" ::: "memory")
#define PG8_WAIT_L(n) asm volatile("s_waitcnt lgkmcnt(" #n ")" ::: "memory")
#define PG8_BAR __builtin_amdgcn_s_barrier()
#define PG8_SCHED __builtin_amdgcn_sched_barrier(0)
    Unit cur, nxt; int ui = 0;
    if (!S.next(0, cur)) return;
    f32x4 acc[2][2][4][2];
#pragma unroll
    for (int a = 0; a < 2; ++a)
#pragma unroll
        for (int b = 0; b < 2; ++b)
#pragma unroll
            for (int m = 0; m < 4; ++m)
#pragma unroll
                for (int n = 0; n < 2; ++n) acc[a][b][m][n] = (f32x4){0.f, 0.f, 0.f, 0.f};
    bf16x8 At[4][2], B0[2][2], B1[2][2];
    const char* cA = PG8_UA(cur); const char* cB = PG8_UB(cur);
    if constexpr (SP2) {
        PG8_STAGE(PG8_SB(0, 0), cB, voffB); PG8_STAGE(PG8_SB(0, 1), cB + hstepB, voffB); PG8_STAGE(PG8_SA(0, 0), cA, voffA); PG8_STAGE(PG8_SA(0, 1), cA + hstepA, voffA);
        if (wr == 1) PG8_BAR;
        PG8_WAIT_V(2); PG8_BAR;
        PG8_STAGE(PG8_SB(1, 0), cB + kstep, voffB); PG8_STAGE(PG8_SA(1, 0), cA + kstep, voffA); PG8_STAGE(PG8_SB(1, 1), cB + hstepB + kstep, voffB);
        PG8_WAIT_V(6); PG8_BAR;
    } else {
        PG8_STAGE(PG8_SB(0, 0), cB, voffB); PG8_STAGE(PG8_SA(0, 0), cA, voffA); PG8_STAGE(PG8_SB(0, 1), cB + hstepB, voffB); PG8_STAGE(PG8_SA(0, 1), cA + hstepA, voffA);
        if (wr == 1) PG8_BAR;
        PG8_WAIT_V(4); PG8_BAR;
        PG8_STAGE(PG8_SB(1, 0), cB + kstep, voffB); PG8_STAGE(PG8_SA(1, 0), cA + kstep, voffA); PG8_STAGE(PG8_SB(1, 1), cB + hstepB + kstep, voffB);
        PG8_WAIT_V(6); PG8_BAR;
    }
    for (;;) {
        const bool has_next = S.next(ui + 1, nxt);
        const char* nA = has_next ? PG8_UA(nxt) : cA; const char* nB = has_next ? PG8_UB(nxt) : cB;
        for (int t = 0; t < nt; t += 2) {
            const bool last = (t == nt - 2);
            const char* a1 = cA + (size_t)(t + 1) * kstep;
            const char* a2 = last ? nA : cA + (size_t)(t + 2) * kstep; const char* b2 = last ? nB : cB + (size_t)(t + 2) * kstep;
            const char* a3 = a2 + kstep; const char* b3 = b2 + kstep;
            if constexpr (SP2) {
            PG8_LDB(B0, 0, 0); PG8_LDB(B1, 0, 1); PG8_SCHED; PG8_LDA(At, 0, 0); PG8_STAGE(PG8_SA(1, 1), a1 + hstepA, voffA);
            PG8_WAIT_V(8); PG8_WAIT_L(0); PG8_BAR; PG8_MMA(0, 0, At, B0); PG8_MMA(0, 1, At, B1); PG8_BAR; PG8_SCHED;
            PG8_LDA(At, 0, 1); PG8_STAGE(PG8_SB(0, 0), b2, voffB); PG8_STAGE(PG8_SB(0, 1), b2 + hstepB, voffB); PG8_STAGE(PG8_SA(0, 0), a2, voffA);
            PG8_WAIT_V(8); PG8_WAIT_L(0); PG8_BAR; PG8_MMA(1, 0, At, B0); PG8_MMA(1, 1, At, B1); PG8_BAR; PG8_SCHED;
            PG8_LDB(B0, 1, 0); PG8_LDB(B1, 1, 1); PG8_SCHED; PG8_LDA(At, 1, 0); PG8_STAGE(PG8_SA(0, 1), a2 + hstepA, voffA);
            PG8_WAIT_V(8); PG8_WAIT_L(0); PG8_BAR; PG8_MMA(0, 0, At, B0); PG8_MMA(0, 1, At, B1); PG8_BAR; PG8_SCHED;
            PG8_LDA(At, 1, 1); PG8_STAGE(PG8_SB(1, 0), b3, voffB); PG8_STAGE(PG8_SB(1, 1), b3 + hstepB, voffB); PG8_STAGE(PG8_SA(1, 0), a3, voffA);
            PG8_WAIT_V(8); PG8_WAIT_L(0); PG8_BAR; PG8_MMA(1, 0, At, B0); PG8_MMA(1, 1, At, B1); PG8_BAR; PG8_SCHED;
            } else {
            PG8_LDB(B0, 0, 0); PG8_SCHED; PG8_LDA(At, 0, 0); PG8_STAGE(PG8_SA(1, 1), a1 + hstepA, voffA);
            PG8_WAIT_L(8); PG8_BAR; PG8_WAIT_L(0); PG8_MMA(0, 0, At, B0); PG8_BAR; PG8_SCHED;
            PG8_LDB(B1, 0, 1); PG8_STAGE(PG8_SB(0, 0), b2, voffB);
            PG8_BAR; PG8_WAIT_L(0); PG8_MMA(0, 1, At, B1); PG8_BAR;
            PG8_LDA(At, 0, 1); PG8_STAGE(PG8_SA(0, 0), a2, voffA);
            PG8_BAR; PG8_WAIT_L(0); PG8_MMA(1, 0, At, B0); PG8_BAR; PG8_SCHED;
            PG8_STAGE(PG8_SB(0, 1), b2 + hstepB, voffB);
            PG8_WAIT_V(6); PG8_BAR; PG8_MMA(1, 1, At, B1); PG8_BAR;
            PG8_LDB(B0, 1, 0); PG8_SCHED; PG8_LDA(At, 1, 0); PG8_STAGE(PG8_SA(0, 1), a2 + hstepA, voffA);
            PG8_WAIT_L(8); PG8_BAR; PG8_WAIT_L(0); PG8_MMA(0, 0, At, B0); PG8_BAR; PG8_SCHED;
            PG8_LDB(B1, 1, 1); PG8_STAGE(PG8_SB(1, 0), b3, voffB);
            PG8_BAR; PG8_WAIT_L(0); PG8_MMA(0, 1, At, B1); PG8_BAR;
            PG8_LDA(At, 1, 1); PG8_STAGE(PG8_SA(1, 0), a3, voffA);
            PG8_BAR; PG8_WAIT_L(0); PG8_MMA(1, 0, At, B0); PG8_BAR; PG8_SCHED;
            PG8_STAGE(PG8_SB(1, 1), b3 + hstepB, voffB);
            PG8_WAIT_V(6); PG8_BAR; PG8_MMA(1, 1, At, B1); PG8_BAR;
            }
        }
        if constexpr (ALIGN_EPI) { if (wr == 0) PG8_BAR; }
        if constexpr (!Epi::AFTER_DRAIN) { E(acc, cur, wr, wc, fr, fq); }
        if (!has_next) break;
#pragma unroll
        for (int a = 0; a < 2; ++a)
#pragma unroll
            for (int b = 0; b < 2; ++b)
#pragma unroll
                for (int m = 0; m < 4; ++m)
#pragma unroll
                    for (int n = 0; n < 2; ++n) acc[a][b][m][n] = (f32x4){0.f, 0.f, 0.f, 0.f};
        cur = nxt; cA = nA; cB = nB; ++ui;
        if constexpr (ALIGN_EPI) { if (wr == 1) PG8_BAR; }
    }
    PG8_WAIT_V(0);
    if constexpr (!ALIGN_EPI) { if (wr == 0) PG8_BAR; }
    PG8_BAR;
    if constexpr (Epi::AFTER_DRAIN) { E.fused(acc, cur, wr, wc, fr, fq, lds, wid, lane); }
#undef PG8_UA
#undef PG8_UB
#undef PG8_SA
#undef PG8_SB
#undef PG8_STAGE
#undef PG8_LDA
#undef PG8_LDB
#undef PG8_MMA
#undef PG8_WAIT_V
#undef PG8_WAIT_L
#undef PG8_BAR
#undef PG8_SCHED
}
}

struct TItem { const float* W; bf16_t* WT; const float* gk; int K, N, drow0, k0, n0; bool valid; };
__device__ __forceinline__ void ti_load(const TItem& t, f32x4 (&v)[16], int lane) {
    const int lr = lane >> 4, lc = (lane & 15) * 4;
    if (t.valid) {
#pragma unroll
        for (int i = 0; i < 16; ++i) v[i] = *(const f32x4*)(t.W + (size_t)(t.k0 + 4 * i + lr) * t.N + t.n0 + lc);
    }
}
__device__ __forceinline__ void ti_finish(const TItem& t, f32x4 (&v)[16], LAS float* scr, int lane) {
    if (!t.valid) return;
    const int lr = lane >> 4, lc = (lane & 15) * 4;
    const int c = lane & 7;
    f32x4 g0 = (f32x4){1.f, 1.f, 1.f, 1.f}, g1 = g0;
    if (t.gk) { g0 = *(const f32x4*)(t.gk + t.k0 + 8 * c); g1 = *(const f32x4*)(t.gk + t.k0 + 8 * c + 4); }
#pragma unroll
    for (int i = 0; i < 16; ++i) { LAS float* s = scr + (4 * i + lr) * 65 + lc; s[0] = v[i].x; s[1] = v[i].y; s[2] = v[i].z; s[3] = v[i].w; }
    asm volatile("s_waitcnt lgkmcnt(0)" ::: "memory");
#pragma unroll
    for (int j = 0; j < 8; ++j) { const int n = (lane >> 3) + 8 * j; const LAS float* s = scr + (8 * c) * 65 + n;
        u32x4 o; o.x = cvt_pk_bf16(s[0 * 65] * g0.x, s[1 * 65] * g0.y); o.y = cvt_pk_bf16(s[2 * 65] * g0.z, s[3 * 65] * g0.w); o.z = cvt_pk_bf16(s[4 * 65] * g1.x, s[5 * 65] * g1.y); o.w = cvt_pk_bf16(s[6 * 65] * g1.z, s[7 * 65] * g1.w);
        *(u32x4*)(t.WT + (size_t)(t.drow0 + n) * t.K + t.k0 + 8 * c) = o; }
    asm volatile("s_waitcnt lgkmcnt(0)" ::: "memory");
}

template <bool HAS_Y, bool HAS_XN>
__device__ __forceinline__ void rowpass(const float* xin, float* xout, const bf16_t* Y, const float* gpost, float wgt, bf16_t* XN, const float* gpre, int nrows, int gw, int NGW, int lane_in) {
    int lane = lane_in; asm volatile("" : "+v"(lane));
    for (int m = gw; m < nrows; m += NGW) {
        const f32x4* xr = (const f32x4*)(xin + (size_t)m * DM) + lane;
        f32x4 v[4];
#pragma unroll
        for (int j = 0; j < 4; ++j) v[j] = xr[64 * j];
        if constexpr (HAS_Y) {
            const u32x2* yr = (const u32x2*)(Y + (size_t)m * DM) + lane;
            f32x4 y[4]; float ss = 0.f;
#pragma unroll
            for (int j = 0; j < 4; ++j) { const u32x2 w = yr[64 * j]; y[j] = (f32x4){bf_lo(w.x), bf_hi(w.x), bf_lo(w.y), bf_hi(w.y)};
                ss += (y[j].x * y[j].x + y[j].y * y[j].y) + (y[j].z * y[j].z + y[j].w * y[j].w); }
            ss = wave_sum(ss);
            const float rs = wgt / sqrtf(ss * (1.0f / DM) + EPS);
#pragma unroll
            for (int j = 0; j < 4; ++j) { const f32x4 g = ((const f32x4*)gpost)[lane + 64 * j]; v[j] = v[j] + y[j] * g * rs; }
        }
        if (xout) { f32x4* xo = (f32x4*)(xout + (size_t)m * DM) + lane;
#pragma unroll
            for (int j = 0; j < 4; ++j) xo[64 * j] = v[j]; }
        if constexpr (HAS_XN) {
            float s2 = 0.f;
#pragma unroll
            for (int j = 0; j < 4; ++j) s2 += (v[j].x * v[j].x + v[j].y * v[j].y) + (v[j].z * v[j].z + v[j].w * v[j].w);
            s2 = wave_sum(s2);
            const float rs2 = 1.0f / sqrtf(s2 * (1.0f / DM) + EPS);
            u32x2* xo = (u32x2*)(XN + (size_t)m * DM) + lane;
#pragma unroll
            for (int j = 0; j < 4; ++j) { const f32x4 g = ((const f32x4*)gpre)[lane + 64 * j]; const f32x4 o = v[j] * g * rs2;
                u32x2 w; w.x = cvt_pk_bf16(o.x, o.y); w.y = cvt_pk_bf16(o.z, o.w); xo[64 * j] = w; }
        }
    }
}

__device__ __forceinline__ void rowpass0(const float* xin, bf16_t* XB, float* rstd, int gw, int NGW, int lane_in) {
    int lane = lane_in; asm volatile("" : "+v"(lane));
    for (int m = gw; m < NTOK; m += 2 * NGW) {
        const int m2 = m + NGW;
        const f32x4* xr = (const f32x4*)(xin + (size_t)m * DM) + lane; const f32x4* xr2 = (const f32x4*)(xin + (size_t)m2 * DM) + lane;
        f32x4 va[4], vb[4];
#pragma unroll
        for (int j = 0; j < 4; ++j) { va[j] = xr[64 * j]; vb[j] = xr2[64 * j]; }
        u32x2* xo = (u32x2*)(XB + (size_t)m * DM) + lane; u32x2* xo2 = (u32x2*)(XB + (size_t)m2 * DM) + lane;
        float s2 = 0.f, t2 = 0.f;
#pragma unroll
        for (int j = 0; j < 4; ++j) {
            u32x2 w; w.x = cvt_pk_bf16(va[j].x, va[j].y); w.y = cvt_pk_bf16(va[j].z, va[j].w); xo[64 * j] = w;
            { const float a = bf_lo(w.x), b = bf_hi(w.x), c = bf_lo(w.y), d = bf_hi(w.y); s2 += (a * a + b * b) + (c * c + d * d); }
            u32x2 w2; w2.x = cvt_pk_bf16(vb[j].x, vb[j].y); w2.y = cvt_pk_bf16(vb[j].z, vb[j].w); xo2[64 * j] = w2;
            { const float a = bf_lo(w2.x), b = bf_hi(w2.x), c = bf_lo(w2.y), d = bf_hi(w2.y); t2 += (a * a + b * b) + (c * c + d * d); }
        }
        s2 = wave_sum(s2); t2 = wave_sum(t2);
        if (lane == 0) { *(f32x4*)(rstd + 4 * (size_t)m) = (f32x4){s2, 0.f, 0.f, 0.f}; *(f32x4*)(rstd + 4 * (size_t)m2) = (f32x4){t2, 0.f, 0.f, 0.f}; }
    }
}
__device__ __forceinline__ void wave_sum8(float (&v)[8]) {
#pragma unroll
    for (int i = 0; i < 8; ++i) v[i] += shx<1>(v[i]);
#pragma unroll
    for (int i = 0; i < 8; ++i) v[i] += shx<2>(v[i]);
#pragma unroll
    for (int i = 0; i < 8; ++i) v[i] += shx<4>(v[i]);
#pragma unroll
    for (int i = 0; i < 8; ++i) v[i] += shx<8>(v[i]);
#pragma unroll
    for (int i = 0; i < 8; ++i) v[i] += shx<16>(v[i]);
#pragma unroll
    for (int i = 0; i < 8; ++i) v[i] = sum32(v[i]);
}
__device__ __forceinline__ void light_mixers_tile(LAS unsigned char* lds, const bf16_t* Z, bf16_t* YC, int tl, const float* pool_w, const float* pool_scale, const float* sconv_w,
                                                  const float* dw_w, const float* dw_b, const float* ln_g, const float* ln_b, int wid0) {
    int tid = wid0 * 64 + lane_id(); asm volatile("" : "+v"(tid));
    const int lane = tid & 63, wid = tid >> 6;
    const int tok0 = tl * 64, s0 = tok0 % SEQ;
    float scw[3][8];
#pragma unroll
    for (int j = 0; j < 3; ++j)
#pragma unroll
        for (int i = 0; i < 8; ++i) scw[j][i] = sconv_w[j * 256 + (tid & 31) * 8 + i];
    u32x4 sco[4];
#pragma unroll
    for (int k = 0; k < 4; ++k) { const int it = tid + 512 * k;
        const int t = it >> 5, c8 = (it & 31) * 8; const int s = s0 + t; const bf16_t* zr = Z + (size_t)(tok0 + t) * ZLD;
        float xs[8], cgv[8], bg[8], p0[8], p1[8], p2[8];
        ld8(zr + 256 + c8, xs); ld8(zr + 768 + c8, cgv); ld8(zr + 512 + c8, bg);
#pragma unroll
        for (int i = 0; i < 8; ++i) p2[i] = xs[i] * cgv[i];
        if (s >= 1) { ld8(zr - ZLD + 256 + c8, xs); ld8(zr - ZLD + 768 + c8, cgv);
#pragma unroll
            for (int i = 0; i < 8; ++i) p1[i] = xs[i] * cgv[i]; }
        else {
#pragma unroll
            for (int i = 0; i < 8; ++i) p1[i] = 0.f; }
        if (s >= 2) { ld8(zr - 2 * ZLD + 256 + c8, xs); ld8(zr - 2 * ZLD + 768 + c8, cgv);
#pragma unroll
            for (int i = 0; i < 8; ++i) p0[i] = xs[i] * cgv[i]; }
        else {
#pragma unroll
            for (int i = 0; i < 8; ++i) p0[i] = 0.f; }
        float o[8];
#pragma unroll
        for (int i = 0; i < 8; ++i) o[i] = bg[i] * (scw[0][i] * p0[i] + scw[1][i] * p1[i] + scw[2][i] * p2[i]);
        u32x4 w; w.x = cvt_pk_bf16(o[0], o[1]); w.y = cvt_pk_bf16(o[2], o[3]); w.z = cvt_pk_bf16(o[4], o[5]); w.w = cvt_pk_bf16(o[6], o[7]);
        sco[k] = w;
    }
#pragma unroll
    for (int k = 0; k < 4; ++k) { const int it = tid + 512 * k; *(u32x4*)(YC + (size_t)(tok0 + (it >> 5)) * DM + 256 + (it & 31) * 8) = sco[k]; }
    LAS bf16_t* mxb = (LAS bf16_t*)lds;
    LAS bf16_t* wtb = (LAS bf16_t*)(lds + 34816);
    LAS bf16_t* zb = (LAS bf16_t*)(lds + 73728);
    {   u32x4 zr5[5];
#pragma unroll
        for (int k = 0; k < 5; ++k) { const int it = tid + 512 * k; const int i = it >> 5, c8 = (it & 31) * 8; const int s = s0 - 15 + i;
            zr5[k] = (u32x4){0u, 0u, 0u, 0u};
            if (it < 79 * 32 && s >= 0) zr5[k] = *(const u32x4*)(Z + (size_t)(tok0 - 15 + i) * ZLD + c8); }
#pragma unroll
        for (int k = 0; k < 5; ++k) { const int it = tid + 512 * k; if (it < 79 * 32) *(LAS u32x4*)(zb + (it >> 5) * 256 + (it & 31) * 8) = zr5[k]; }
    }
#pragma unroll
    for (int e0 = 0; e0 < 16384; e0 += 512 * 8) {
        float pw[8];
#pragma unroll
        for (int k = 0; k < 8; ++k) pw[k] = pool_w[e0 + 512 * k + tid];
#pragma unroll
        for (int k = 0; k < 8; ++k) { const int e = e0 + 512 * k + tid; const int g = e >> 12, c = (e >> 6) & 63, d = e & 63; wtb[(g * 64 + d) * 72 + c] = (bf16_t)(cvt_pk_bf16(pw[k], 0.f) & 0xffffu); }
    }
    __syncthreads();
    for (int it = tid; it < 64 * 32; it += 512) {
        const int t = it >> 5, c8 = (it & 31) * 8; const int s = s0 + t; const int g = c8 >> 6, w = 2 << g; const int cnt = (s + 1 < w) ? (s + 1) : w;
        float cur[8], sum[8];
        { const u32x4 q = *(const LAS u32x4*)(zb + (15 + t) * 256 + c8);
          cur[0] = bf_lo(q.x); cur[1] = bf_hi(q.x); cur[2] = bf_lo(q.y); cur[3] = bf_hi(q.y); cur[4] = bf_lo(q.z); cur[5] = bf_hi(q.z); cur[6] = bf_lo(q.w); cur[7] = bf_hi(q.w); }
#pragma unroll
        for (int i = 0; i < 8; ++i) sum[i] = cur[i];
        for (int j = 1; j < w; ++j) { const u32x4 q = *(const LAS u32x4*)(zb + (15 + t - j) * 256 + c8);
            sum[0] += bf_lo(q.x); sum[1] += bf_hi(q.x); sum[2] += bf_lo(q.y); sum[3] += bf_hi(q.y); sum[4] += bf_lo(q.z); sum[5] += bf_hi(q.z); sum[6] += bf_lo(q.w); sum[7] += bf_hi(q.w); }
        const float ic = 1.0f / (float)cnt;
        u32x4 o; o.x = cvt_pk_bf16(sum[0] * ic - cur[0], sum[1] * ic - cur[1]); o.y = cvt_pk_bf16(sum[2] * ic - cur[2], sum[3] * ic - cur[3]);
        o.z = cvt_pk_bf16(sum[4] * ic - cur[4], sum[5] * ic - cur[5]); o.w = cvt_pk_bf16(sum[6] * ic - cur[6], sum[7] * ic - cur[7]);
        *(LAS u32x4*)(mxb + t * 264 + c8) = o;
    }
    __syncthreads();
    {
        const int g = wid >> 1, tb = wid & 1, r32 = lane & 31, hi = lane >> 5;
        f32x16 acc0 = {}, acc1 = {};
#pragma unroll
        for (int ks = 0; ks < 4; ++ks) {
            const bf16x8 bm = *(const LAS bf16x8*)(mxb + (tb * 32 + r32) * 264 + g * 64 + ks * 16 + hi * 8);
            const bf16x8 a0 = *(const LAS bf16x8*)(wtb + (g * 64 + r32) * 72 + ks * 16 + hi * 8), a1 = *(const LAS bf16x8*)(wtb + (g * 64 + 32 + r32) * 72 + ks * 16 + hi * 8);
            acc0 = __builtin_amdgcn_mfma_f32_32x32x16_bf16(a0, bm, acc0, 0, 0, 0);
            acc1 = __builtin_amdgcn_mfma_f32_32x32x16_bf16(a1, bm, acc1, 0, 0, 0);
        }
        bf16_t* op = YC + (size_t)(tok0 + tb * 32 + r32) * DM + g * 64;
        f32x4 sav[4], sbv[4];
#pragma unroll
        for (int rg = 0; rg < 4; ++rg) { sav[rg] = *(const f32x4*)(pool_scale + g * 64 + 8 * rg + 4 * hi); sbv[rg] = *(const f32x4*)(pool_scale + g * 64 + 32 + 8 * rg + 4 * hi); }
#pragma unroll
        for (int rg = 0; rg < 4; ++rg) { const int d0 = 8 * rg + 4 * hi;
            const f32x4 sa = sav[rg], sb = sbv[rg];
            u32x2 wa, wb;
            wa.x = cvt_pk_bf16(acc0[4 * rg + 0] * sa.x, acc0[4 * rg + 1] * sa.y); wa.y = cvt_pk_bf16(acc0[4 * rg + 2] * sa.z, acc0[4 * rg + 3] * sa.w);
            wb.x = cvt_pk_bf16(acc1[4 * rg + 0] * sb.x, acc1[4 * rg + 1] * sb.y); wb.y = cvt_pk_bf16(acc1[4 * rg + 2] * sb.z, acc1[4 * rg + 3] * sb.w);
            *(u32x2*)(op + d0) = wa; *(u32x2*)(op + 32 + d0) = wb; }
    }
    __syncthreads();
    LAS bf16_t* ub = (LAS bf16_t*)lds; LAS float* cv = (LAS float*)(lds + 49152);
    {   u32x4 gaw[6], ggw[6];
#pragma unroll
        for (int k = 0; k < 6; ++k) { const int it = tid + 512 * k; const int i = it >> 5, c8 = (it & 31) * 8; const int s = s0 - 30 + i;
            gaw[k] = (u32x4){0u, 0u, 0u, 0u}; ggw[k] = gaw[k];
            if (it < 94 * 32 && s >= 0) { const bf16_t* zr = Z + (size_t)(tok0 - 30 + i) * ZLD; gaw[k] = *(const u32x4*)(zr + 1536 + c8); ggw[k] = *(const u32x4*)(zr + 1792 + c8); } }
#pragma unroll
        for (int k = 0; k < 6; ++k) { const int it = tid + 512 * k;
            float ga[8], gg[8], e[8];
            ga[0] = bf_lo(gaw[k].x); ga[1] = bf_hi(gaw[k].x); ga[2] = bf_lo(gaw[k].y); ga[3] = bf_hi(gaw[k].y); ga[4] = bf_lo(gaw[k].z); ga[5] = bf_hi(gaw[k].z); ga[6] = bf_lo(gaw[k].w); ga[7] = bf_hi(gaw[k].w);
            gg[0] = bf_lo(ggw[k].x); gg[1] = bf_hi(ggw[k].x); gg[2] = bf_lo(ggw[k].y); gg[3] = bf_hi(ggw[k].y); gg[4] = bf_lo(ggw[k].z); gg[5] = bf_hi(ggw[k].z); gg[6] = bf_lo(ggw[k].w); gg[7] = bf_hi(ggw[k].w);
#pragma unroll
            for (int q = 0; q < 8; ++q) e[q] = fast_exp2(-1.4426950408889634f * gg[q]);
#pragma unroll
            for (int q = 0; q < 8; ++q) e[q] = fast_rcp(1.0f + e[q]);
#pragma unroll
            for (int q = 0; q < 8; ++q) e[q] *= ga[q];
            u32x4 w; w.x = cvt_pk_bf16(e[0], e[1]); w.y = cvt_pk_bf16(e[2], e[3]); w.z = cvt_pk_bf16(e[4], e[5]); w.w = cvt_pk_bf16(e[6], e[7]);
            if (it < 94 * 32) *(LAS u32x4*)(ub + (it >> 5) * 256 + (it & 31) * 8) = w; }
    }
    __syncthreads();
    {
        const int ch = tid & 255, half = tid >> 8;
        float wt[31];
#pragma unroll
        for (int j = 0; j < 31; ++j) wt[j] = dw_w[j * 256 + ch];
        const float bias = dw_b[ch];
        float uu[62];
#pragma unroll
        for (int i = 0; i < 62; ++i) uu[i] = bf2f(ub[(half * 32 + i) * 256 + ch]);
#pragma unroll
        for (int t = 0; t < 32; ++t) {
            float a = bias;
#pragma unroll
            for (int j = 0; j < 31; ++j) a += wt[j] * uu[t + j];
            cv[(half * 32 + t) * 256 + ch] = a;
        }
    }
    __syncthreads();
    {
        const f32x4 g4 = ((const f32x4*)ln_g)[lane], b4 = ((const f32x4*)ln_b)[lane];
        f32x4 v[8]; float sm[8];
#pragma unroll
        for (int i = 0; i < 8; ++i) { v[i] = *(const LAS f32x4*)(cv + (wid * 8 + i) * 256 + 4 * lane); sm[i] = (v[i].x + v[i].y) + (v[i].z + v[i].w); }
        wave_sum8(sm);
#pragma unroll
        for (int i = 0; i < 8; ++i) { v[i] = v[i] - sm[i] * (1.0f / 256.0f); sm[i] = (v[i].x * v[i].x + v[i].y * v[i].y) + (v[i].z * v[i].z + v[i].w * v[i].w); }
        wave_sum8(sm);
        u32x2 ow[8];
#pragma unroll
        for (int i = 0; i < 8; ++i) { const float rs = __builtin_amdgcn_rsqf(sm[i] * (1.0f / 256.0f) + EPS);
            const f32x4 y = v[i] * rs * g4 + b4;
            float e0 = fast_exp2(-1.4426950408889634f * y.x), e1 = fast_exp2(-1.4426950408889634f * y.y), e2 = fast_exp2(-1.4426950408889634f * y.z), e3 = fast_exp2(-1.4426950408889634f * y.w);
            e0 = fast_rcp(1.0f + e0); e1 = fast_rcp(1.0f + e1); e2 = fast_rcp(1.0f + e2); e3 = fast_rcp(1.0f + e3);
            ow[i].x = cvt_pk_bf16(y.x * e0, y.y * e1); ow[i].y = cvt_pk_bf16(y.z * e2, y.w * e3); }
#pragma unroll
        for (int i = 0; i < 8; ++i) *(u32x2*)(YC + (size_t)(tok0 + wid * 8 + i) * DM + 768 + 4 * lane) = ow[i];
    }
    __syncthreads();
}

constexpr int DA_KST = 144, DA_VST = 272, DA_KB = 128 * DA_KST, DA_VB = 64 * DA_VST, DA_BUF = DA_KB + DA_VB;
__device__ __forceinline__ float fadd_s(float a, float b) { float r; asm("v_add_f32_e32 %0, %1, %2" : "=v"(r) : "v"(a), "v"(b)); return r; }
template <int NH, bool FIRST>
__device__ __forceinline__ float da_step(const LAS unsigned char* kb, int kroff, int vroff, const bf16x8 (&qr)[2], f32x16& o0, f32x16& o1, f32x16& osum, f32x16& negm, float& mhat) {
    const bf16x8 ones = (bf16x8){0x3F80, 0x3F80, 0x3F80, 0x3F80, 0x3F80, 0x3F80, 0x3F80, 0x3F80};
    float rmax = -INFINITY;
#pragma unroll
    for (int g = 0; g < NH; ++g) {
        const LAS unsigned char* kg = kb + kroff + g * 64 * DA_KST;
        const bf16x8 k0 = *(const LAS bf16x8*)(kg), k1 = *(const LAS bf16x8*)(kg + 32 * DA_KST);
        const bf16x8 k2 = *(const LAS bf16x8*)(kg + 32), k3 = *(const LAS bf16x8*)(kg + 32 * DA_KST + 32);
        f32x16 pa = __builtin_amdgcn_mfma_f32_32x32x16_bf16(k0, qr[0], negm, 0, 0, 0);
        f32x16 pc = __builtin_amdgcn_mfma_f32_32x32x16_bf16(k1, qr[0], negm, 0, 0, 0);
        pa = __builtin_amdgcn_mfma_f32_32x32x16_bf16(k2, qr[1], pa, 0, 0, 0);
        pc = __builtin_amdgcn_mfma_f32_32x32x16_bf16(k3, qr[1], pc, 0, 0, 0);
        bf16x8 vfa[2][2], vfb[2][2];
#pragma unroll
        for (int hh = 0; hh < 2; ++hh)
#pragma unroll
            for (int s = 0; s < 2; ++s) { const LAS unsigned char* vp = kb + DA_KB + vroff + (2 * g + hh) * 64 + s * 32;
                vfa[hh][s] = *(const LAS bf16x8*)(vp); vfb[hh][s] = *(const LAS bf16x8*)(vp + 32 * DA_VST); }
        __builtin_amdgcn_sched_barrier(0);
        if constexpr (FIRST) {
            if (g == 0) {
                float ra = fmaxf(fmaxf(pa[0], pa[1]), pc[0]), rb = fmaxf(fmaxf(pa[2], pa[3]), pc[1]);
                ra = fmaxf(fmaxf(ra, pc[2]), pc[3]);
#pragma unroll
                for (int r = 4; r < 16; r += 4) { ra = fmaxf(fmaxf(ra, pa[r]), pa[r + 1]); rb = fmaxf(fmaxf(rb, pa[r + 2]), pa[r + 3]); ra = fmaxf(fmaxf(ra, pc[r]), pc[r + 1]); rb = fmaxf(fmaxf(rb, pc[r + 2]), pc[r + 3]); }
                rmax = fmaxf(ra, rb);
            }
        }
        if constexpr (FIRST) {
            if (g == 0) {
                const float ra = max32(rmax); mhat = ra; rmax = 0.f;
#pragma unroll
                for (int r = 0; r < 16; ++r) { pa[r] -= ra; pc[r] -= ra; negm[r] = -mhat; }
            }
        }
#pragma unroll
        for (int r = 0; r < 16; r += 2) { pa[r] = fast_exp2(pa[r]); pa[r + 1] = fast_exp2(pa[r + 1]); }
#pragma unroll
        for (int r = 0; r < 16; r += 2) { pc[r] = fast_exp2(pc[r]); pc[r + 1] = fast_exp2(pc[r + 1]); }
        bf16x8 pb[2][2];
#pragma unroll
        for (int hh = 0; hh < 2; ++hh)
#pragma unroll
            for (int s = 0; s < 2; ++s) { const f32x16& q = hh ? pc : pa; u32x4 w;
                w.x = cvtpk_s(q[8 * s + 0], q[8 * s + 1]); w.y = cvtpk_s(q[8 * s + 2], q[8 * s + 3]); w.z = cvtpk_s(q[8 * s + 4], q[8 * s + 5]); w.w = cvtpk_s(q[8 * s + 6], q[8 * s + 7]);
                pb[hh][s] = __builtin_bit_cast(bf16x8, w); }
#pragma unroll
        for (int hh = 0; hh < 2; ++hh)
#pragma unroll
            for (int s = 0; s < 2; ++s) {
                o0 = __builtin_amdgcn_mfma_f32_32x32x16_bf16(vfa[hh][s], pb[hh][s], o0, 0, 0, 0);
                o1 = __builtin_amdgcn_mfma_f32_32x32x16_bf16(vfb[hh][s], pb[hh][s], o1, 0, 0, 0);
                osum = __builtin_amdgcn_mfma_f32_32x32x16_bf16(ones, pb[hh][s], osum, 0, 0, 0);
            }
    }
    return rmax;
}
__device__ __forceinline__ void dattn_unit(LAS unsigned char* lds, const bf16_t* QC, const bf16_t* VT, bf16_t* YC, int b, int h, int u128, float lam, float oscale, const float* subg, int wid0) {
    int tid = wid0 * 64 + lane_id(); asm volatile("" : "+v"(tid));
    const int lane = tid & 63, r32 = lane & 31, hi = lane >> 5; const int wid = __builtin_amdgcn_readfirstlane(tid >> 6);
    const int comp = wid >> 2, wq = wid & 3;
    const size_t tok0 = (size_t)b * SEQ; const int q0 = u128 * 128;
    const bf16_t* KC = QC + (size_t)8 * 8192 * 64;
    const bf16_t* qp = QC + ((size_t)(b * 4 + h) * 8192 + q0 + wq * 32 + r32) * 64 + comp * 32 + hi * 8;
    bf16x8 qr[2]; qr[0] = *(const bf16x8*)qp; qr[1] = *(const bf16x8*)(qp + 16);
    const int NS = u128 + 1;
    const int srow = tid >> 3, sch = tid & 7;
    const bf16_t* ksrc = KC + ((size_t)(b * 4 + h) * 8192 + srow) * 64 + sch * 8;
    const bf16_t* vsrc = VT + (size_t)(h * 64 + srow) * NTOK + tok0 + sch * 8;
    const int kwoff = srow * DA_KST + sch * 16, vwoff = DA_KB + srow * DA_VST + sch * 16;
    const int rsw = (r32 & 0x13) | ((r32 & 4) << 1) | ((r32 & 8) >> 1);
    const int kroff = rsw * DA_KST + comp * 64 + hi * 16;
    const int vroff = r32 * DA_VST + hi * 16;
    f32x16 o0 = {}, o1 = {}, osum = {}; float mhat = 0.f;
    f32x16 negm = {};
    {   const u32x4 k0 = *(const u32x4*)ksrc, k1 = *(const u32x4*)(ksrc + 64 * 64), v0 = *(const u32x4*)vsrc, v1 = *(const u32x4*)(vsrc + 64);
        *(LAS u32x4*)(lds + kwoff) = k0; *(LAS u32x4*)(lds + kwoff + 64 * DA_KST) = k1; *(LAS u32x4*)(lds + vwoff) = v0; *(LAS u32x4*)(lds + vwoff + 128) = v1; }
    __syncthreads();
    for (int s = 0; s < NS; ++s) {
        const bool more = (s + 1 < NS);
        u32x4 k0 = (u32x4){0u, 0u, 0u, 0u}, k1 = k0, v0 = k0, v1 = k0;
        if (more) { const bf16_t* kp = ksrc + (size_t)(s + 1) * 128 * 64; const bf16_t* vp = vsrc + (size_t)(s + 1) * 128;
            k0 = *(const u32x4*)kp; k1 = *(const u32x4*)(kp + 64 * 64); v0 = *(const u32x4*)vp; v1 = *(const u32x4*)(vp + 64); }
        const LAS unsigned char* kb = lds + (s & 1) * DA_BUF;
        if ((s & 1) == 0 && s > 0 && __builtin_expect(__any(osum[0] > 16777216.f), 0)) {
            asm volatile("" ::: "memory");
            const float dl = fmaxf(floorf(__log2f(fmaxf(osum[0], 1.0f))), 0.f); const float alpha = fast_exp2(-dl); mhat += dl;
#pragma unroll
            for (int r = 0; r < 16; ++r) { o0[r] *= alpha; o1[r] *= alpha; osum[r] *= alpha; negm[r] = -mhat; }
        }
        if (s == 0) { if (more || wq >= 2) (void)da_step<2, true>(kb, kroff, vroff, qr, o0, o1, osum, negm, mhat); else (void)da_step<1, true>(kb, kroff, vroff, qr, o0, o1, osum, negm, mhat); }
        else if (more || wq >= 2) (void)da_step<2, false>(kb, kroff, vroff, qr, o0, o1, osum, negm, mhat);
        else (void)da_step<1, false>(kb, kroff, vroff, qr, o0, o1, osum, negm, mhat);
        if (more) { LAS unsigned char* nb = lds + ((s + 1) & 1) * DA_BUF;
            *(LAS u32x4*)(nb + kwoff) = k0; *(LAS u32x4*)(nb + kwoff + 64 * DA_KST) = k1; *(LAS u32x4*)(nb + vwoff) = v0; *(LAS u32x4*)(nb + vwoff + 128) = v1; }
        __syncthreads();
    }
    const float inv = 1.0f / osum[0];
    LAS float* X = (LAS float*)lds;
    if (comp == 1) {
        const float f = inv * lam;
#pragma unroll
        for (int r = 0; r < 16; ++r) { X[((wq * 2 + 0) * 16 + r) * 64 + lane] = o0[r] * f; X[((wq * 2 + 1) * 16 + r) * 64 + lane] = o1[r] * f; }
    }
    __syncthreads();
    if (comp == 0) {
        float ss = 0.f;
#pragma unroll
        for (int r = 0; r < 16; ++r) { o0[r] = o0[r] * inv - X[((wq * 2 + 0) * 16 + r) * 64 + lane]; o1[r] = o1[r] * inv - X[((wq * 2 + 1) * 16 + r) * 64 + lane]; ss += o0[r] * o0[r] + o1[r] * o1[r]; }
        ss = sum32(ss);
        float li_ = oscale; asm volatile("" : "+v"(li_));
        const float rs = (1.0f - li_) / sqrtf(ss * (1.0f / 64.0f) + EPS);
        bf16_t* op = YC + (tok0 + q0 + wq * 32 + r32) * DM + 512 + h * 64;
        f32x4 gav[4], gbv[4];
#pragma unroll
        for (int rg = 0; rg < 4; ++rg) { gav[rg] = *(const f32x4*)(subg + 8 * rg + 4 * hi); gbv[rg] = *(const f32x4*)(subg + 32 + 8 * rg + 4 * hi); }
#pragma unroll
        for (int rg = 0; rg < 4; ++rg) {
            const int d0 = 8 * rg + 4 * hi;
            const f32x4 ga = gav[rg], gb = gbv[rg];
            u32x2 wa, wb;
            wa.x = cvt_pk_bf16(o0[4 * rg + 0] * rs * ga.x, o0[4 * rg + 1] * rs * ga.y); wa.y = cvt_pk_bf16(o0[4 * rg + 2] * rs * ga.z, o0[4 * rg + 3] * rs * ga.w);
            wb.x = cvt_pk_bf16(o1[4 * rg + 0] * rs * gb.x, o1[4 * rg + 1] * rs * gb.y); wb.y = cvt_pk_bf16(o1[4 * rg + 2] * rs * gb.z, o1[4 * rg + 3] * rs * gb.w);
            *(u32x2*)(op + d0) = wa; *(u32x2*)(op + 32 + d0) = wb;
        }
    }
    __syncthreads();
}


#define XB_TMO      128
#define XB_XCNT(j)  (256  + 64 * (j))
#define XB_XSUB(j)  (1280 + 64 * (j))
#define XB_XGEN(j)  (2304 + 64 * (j))
#define XB_TOP      3328
#define XB_TOPGEN   3392
#define XCD_BAR_WORDS 3456
#define XB_XGEN1(j) (3456 + 64 * ((j) & 7))
#define XB_SPIN_CAP (1u << 18)
__device__ __forceinline__ unsigned xb_ld(unsigned* p)              { return __hip_atomic_load(p, __ATOMIC_RELAXED, __HIP_MEMORY_SCOPE_AGENT); }
__device__ __forceinline__ unsigned xb_add(unsigned* p, unsigned v) { return __hip_atomic_fetch_add(p, v, __ATOMIC_RELAXED, __HIP_MEMORY_SCOPE_AGENT); }
__device__ __forceinline__ unsigned xb_xcc_id() { return (unsigned)__builtin_amdgcn_s_getreg((3 << 11) | 20) & 0xFu; }
#define XB_SPIN(cond, bar) do { unsigned _sp = 0; while (cond) { __builtin_amdgcn_s_sleep(1); \
    if ((++_sp & 255u) == 0u) { if (xb_ld(&(bar)[XB_TMO])) break; if (_sp > XB_SPIN_CAP) { atomicAdd(&(bar)[XB_TMO], 1u); break; } } } } while (0)
struct XcdBarrier { unsigned* bar; unsigned x; volatile LAS unsigned* st; };
__device__ __forceinline__ XcdBarrier xcd_barrier_post(unsigned* bar, volatile LAS unsigned* st) {
    XcdBarrier b; b.bar = bar; b.x = xb_xcc_id(); b.st = st;
    if (threadIdx.x == 0) (void)xb_add(&bar[XB_XCNT(b.x)], 1u);
    return b;
}
__device__ __forceinline__ void xcd_barrier_complete(unsigned* bar, unsigned x, unsigned& nloc, unsigned& nx) {
    const unsigned G = gridDim.x * gridDim.y * gridDim.z;
    unsigned sum, cnt, mine, sp = 0u;
    for (;;) {
        sum = 0u; cnt = 0u; mine = 0u;
#pragma unroll
        for (unsigned j = 0; j < 16; ++j) { const unsigned c = xb_ld(&bar[XB_XCNT(j)]); sum += c; cnt += (c > 0u) ? 1u : 0u; mine = (j == x) ? c : mine; }
        if (sum == G) break;
        __builtin_amdgcn_s_sleep(1);
        if ((++sp & 255u) == 0u) { if (xb_ld(&bar[XB_TMO])) break; if (sp > XB_SPIN_CAP) { atomicAdd(&bar[XB_TMO], 1u); break; } }
    }
    nloc = mine > 0u ? mine : 1u; nx = cnt > 0u ? cnt : 1u;
}
__device__ __forceinline__ void xcd_barrier(const XcdBarrier& b, int wid0) {
    asm volatile("s_waitcnt vmcnt(0)" ::: "memory");
    __syncthreads();
    if (wid0 == 0 && lane_id() == 0) {
        unsigned* bar = b.bar;
        __builtin_amdgcn_s_waitcnt(0);
        unsigned nloc = b.st[0], nx = b.st[1];
        if (nloc == 0u) { xcd_barrier_complete(bar, b.x, nloc, nx); b.st[0] = nloc; b.st[1] = nx; }
        const unsigned old = xb_add(&bar[XB_XSUB(b.x)], 1u);
        const unsigned gen = old / nloc;
        if (old + 1u == (gen + 1u) * nloc) {
            xb_add(&bar[XB_XGEN1(b.x)], 1u);
            __builtin_amdgcn_fence(__ATOMIC_RELEASE, "agent");
            asm volatile("s_waitcnt vmcnt(0)" ::: "memory");
            const unsigned og = xb_add(&bar[XB_TOP], 1u);
            const unsigned tg = og / nx;
            if (og + 1u == (tg + 1u) * nx) xb_add(&bar[XB_TOPGEN], 1u);
            else XB_SPIN(xb_ld(&bar[XB_TOPGEN]) == tg, bar);
            __builtin_amdgcn_fence(__ATOMIC_ACQUIRE, "agent");
            xb_add(&bar[XB_XGEN(b.x)], 1u);
            asm volatile("s_waitcnt vmcnt(0)" ::: "memory");
        } else {
            XB_SPIN(xb_ld(&bar[XB_XGEN1(b.x)]) == gen, bar);
            __builtin_amdgcn_fence(__ATOMIC_ACQUIRE, "agent");
            asm volatile("s_waitcnt vmcnt(0)" ::: "memory");
            XB_SPIN(xb_ld(&bar[XB_XGEN(b.x)]) == gen, bar);
            asm volatile("s_waitcnt vmcnt(0)" ::: "memory");
        }
    }
    __syncthreads();
}

#define IN(k) ld_ptr(ptab, (k))
__device__ __forceinline__ TItem decode_item(int slot, int idx, int total, volatile LAS unsigned long long* ptab, bf16_t* Wb) {
    TItem t; t.valid = idx < total; t.W = nullptr; t.WT = nullptr; t.gk = nullptr; t.K = 0; t.N = 0; t.drow0 = 0; t.k0 = 0; t.n0 = 0;
    if (!t.valid) return t;
    int l, r;
    if (slot == 0) { if (idx < 2112) { l = 0; r = idx; } else if (idx < 3968) { l = 0; r = idx + 2112; } else { l = 1; r = idx - 3968 + 5312; } }
    else if (slot == 1) { l = 0; r = idx + 2112; }
    else if (slot == 2) { l = 1; r = (idx < 2112) ? idx : idx + 2112; }
    else if (slot == 3) { l = 1; r = idx + 5824; }
    else { l = 1; r = idx + 2112; }
    bf16_t* Wl = Wb + (size_t)l * LW;
    const float* src; int K, N; bf16_t* dst; int kind; int gi = -1;
    if (r < 704) { src = IN(4) + (size_t)l * DM * FF; K = DM; N = FF; dst = Wl + OW_GU1; kind = 1; gi = 3; }
    else if (r < 1408) { r -= 704; src = IN(5) + (size_t)l * DM * FF; K = DM; N = FF; dst = Wl + OW_GU1; kind = 2; gi = 3; }
    else if (r < 2112) { r -= 1408; src = IN(6) + (size_t)l * DM * FF; K = FF; N = DM; dst = Wl + OW_D1; kind = 0; }
    else if (r < 2816) { r -= 2112; src = IN(32) + (size_t)l * DM * FF; K = DM; N = FF; dst = Wl + OW_GU2; kind = 1; gi = 31; }
    else if (r < 3520) { r -= 2816; src = IN(33) + (size_t)l * DM * FF; K = DM; N = FF; dst = Wl + OW_GU2; kind = 2; gi = 31; }
    else if (r < 4224) { r -= 3520; src = IN(34) + (size_t)l * DM * FF; K = FF; N = DM; dst = Wl + OW_D2; kind = 0; }
    else if (r < 4800) { r -= 4224; src = IN(9) + (size_t)l * DM * 2304; K = DM; N = 2304; dst = Wl + OW_IN; kind = 3; gi = 8; }
    else if (r < 5056) { r -= 4800; src = IN(22) + (size_t)l * DM * DM; K = DM; N = DM; dst = Wl + OW_O; kind = 0; }
    else if (r < 5312) { r -= 5056; src = IN(26) + (size_t)l * DM * DM; K = DM; N = DM; dst = Wl + OW_Q; kind = 0; gi = 24; }
    else if (r < 5568) { r -= 5312; src = IN(27) + (size_t)l * DM * DM; K = DM; N = DM; dst = Wl + OW_K; kind = 0; }
    else if (r < 5824) { r -= 5568; src = IN(28) + (size_t)l * DM * DM; K = DM; N = DM; dst = Wl + OW_V; kind = 0; }
    else { r -= 5824; src = IN(29) + (size_t)l * DM * DM; K = DM; N = DM; dst = Wl + OW_XO; kind = 0; }
    const int nblk = N / 64, kb = r / nblk, nb = r % nblk, n0 = 64 * nb;
    int drow0 = n0;
    if (kind == 1) drow0 = (n0 >> 7) * 256 + (n0 & 127);
    else if (kind == 2) drow0 = (n0 >> 7) * 256 + 128 + (n0 & 127);
    else if (kind == 3) { if (n0 >= 1792) drow0 = n0 - 256; else if (n0 >= 1536) drow0 = n0 + 512; }
    if (gi >= 0) t.gk = IN(gi) + l * DM;
    t.W = src; t.WT = dst; t.K = K; t.N = N; t.drow0 = drow0; t.k0 = 64 * kb; t.n0 = n0;
    return t;
}
__device__ __forceinline__ void convert_slot(int slot, int part, int nparts, volatile LAS unsigned long long* ptab, bf16_t* Wb, LAS unsigned char* lds, int wid) {
    const int total = (slot == 0) ? 4480 : (slot == 1) ? 2112 : (slot == 2) ? 3200 : (slot == 3) ? 256 : 2112;
    LAS float* scr = (LAS float*)(lds + wid * 16640);
    int lane = lane_id(); asm volatile("" : "+v"(lane));
    for (int idx0 = part; idx0 < total; idx0 += 2 * nparts) {
        TItem ta, tb; f32x4 va[16], vb[16];
        ta = decode_item(slot, idx0, total, ptab, Wb); tb = decode_item(slot, idx0 + nparts, total, ptab, Wb);
        ti_load(ta, va, lane); ti_load(tb, vb, lane);
        ti_finish(ta, va, scr, lane); ti_finish(tb, vb, scr, lane);
    }
}
#undef IN

__global__ void __launch_bounds__(512, 2) mega_fwd(Params p) {
    extern __shared__ __attribute__((aligned(16))) unsigned char lds_raw[];
    LAS unsigned char* lds = (LAS unsigned char*)lds_raw;
    cg::grid_group grid = cg::this_grid();
    const int wid = __builtin_amdgcn_readfirstlane((int)(threadIdx.x >> 6));
    const int tid = wid * 64 + lane_id();
    const int G = gridDim.x, bx = blockIdx.x;
    const int gw = bx * 8 + wid, NGW = G * 8;
    unsigned char* ws = p.ws;
    bf16_t* Wb = (bf16_t*)(ws + WS_W);
    bf16_t* XN = (bf16_t*)(ws + WS_XN);
    bf16_t* BIG = (bf16_t*)(ws + WS_BIG);
    bf16_t* Yb = (bf16_t*)(ws + WS_Y);
    bf16_t* KV = (bf16_t*)(ws + WS_KV);
    float* RSTD = (float*)(ws + WS_CTL + 131072 + 524288);
    float* SLOTS = (float*)(ws + WS_CTL + 131072);
    unsigned* PCNT = (unsigned*)(ws + WS_CTL + 16384);
    unsigned xk = 0;
#define GSYNC() xcd_barrier(bar, wid)
#define LSYNC() do { asm volatile("s_waitcnt vmcnt(0)" ::: "memory"); __builtin_amdgcn_fence(__ATOMIC_RELEASE, "workgroup"); __syncthreads(); __builtin_amdgcn_fence(__ATOMIC_ACQUIRE, "workgroup"); } while (0)
    volatile LAS unsigned long long* ptab = (volatile LAS unsigned long long*)(lds + 146432 + 128);
    volatile LAS unsigned* bst = (volatile LAS unsigned*)(lds + 146432);
    if (tid == 0) { bst[0] = 0u; bst[1] = 0u; }
    __syncthreads();
    XcdBarrier bar = xcd_barrier_post((unsigned*)(ws + WS_CTL), bst);
    if (tid == 0) {
#pragma unroll
        for (int i = 0; i < 36; ++i) ptab[i] = (unsigned long long)p.in[i];
    }
    __syncthreads();
#define IN(k) ld_ptr(ptab, (k))

    {
        convert_slot(0, gw, NGW, ptab, Wb, lds, wid);
        rowpass0(IN(0), XN, RSTD, gw, NGW, lane_id());
        rowpass<false, true>(IN(1), nullptr, nullptr, nullptr, 0.f, Yb, IN(25), 512, gw, NGW, lane_id());
        rowpass<false, true>(IN(1), nullptr, nullptr, nullptr, 0.f, Yb + 512 * DM, IN(25) + DM, 512, gw, NGW, lane_id());
    }
    grid.sync();
#pragma unroll 1
    for (int i = 0; i < 4; ++i) {
        const int l = i >> 1, isv = i & 1;
        const bf16_t* MN = Yb + (size_t)l * 512 * DM; const bf16_t* Wl = Wb + (size_t)l * LW;
        pg8::Gemm g = isv ? pg8::make_gemm(Wl + OW_V, MN, DM, 512, DM, DM, DM) : pg8::make_gemm(MN, Wl + OW_K, 512, DM, DM, DM, DM);
        pg8::StaticOrder S; S.init(g.M, g.N, G, (bx + 2 * G - 128 - 8 * i) % G);
        pg8::EpiOut E{KV + (size_t)l * 1048576 + (isv ? 524288 : 0), isv ? 512 : DM, 1.0f, nullptr, nullptr};
        pg8::gemm_phase<pg8::EpiOut, pg8::StaticOrder, true, true>(lds, g, S, E, wid);
    }

#pragma unroll 1
    for (int l = 0; l < 2; ++l) {
        const bf16_t* Wl = Wb + (size_t)l * LW;
        const bf16_t* KX = KV + (size_t)l * 1048576; const bf16_t* VXT = KX + 524288;
#pragma unroll 1
        for (int ff = 0; ff < 2; ++ff) {
            if (ff == 1) {
                {
                    pg8::Gemm g = pg8::make_gemm(XN, Wl + OW_IN, NTOK, ZLD, DM, DM, DM);
                    pg8::StaticOrder S; S.init(NTOK, ZLD, G, bx);
                    pg8::EpiWin E{BIG, ZLD, (const int*)IN(2), 0.25503486f, RSTD, BIG + (size_t)NTOK * ZLD + (size_t)256 * NTOK};
                    pg8::gemm_phase<pg8::EpiWin, pg8::StaticOrder, true, true>(lds, g, S, E, wid);
                }
                {
                    pg8::Gemm g = pg8::make_gemm(Wl + OW_IN + (size_t)2048 * DM, XN, 256, NTOK, DM, DM, DM);
                    pg8::StaticOrder S; S.init(256, NTOK, G, bx);
                    pg8::EpiOutCS E{BIG + (size_t)NTOK * ZLD, NTOK, 1.0f, nullptr, RSTD};
                    pg8::gemm_phase<pg8::EpiOutCS, pg8::StaticOrder, true, true>(lds, g, S, E, wid);
                    if (l == 0 && bx >= 64) convert_slot(2, (bx - 64) * 8 + wid, 192 * 8, ptab, Wb, lds, wid);
                }
                GSYNC();
                {
                    bf16_t* YC = Yb; const bf16_t* Z = BIG; const bf16_t* VT = BIG + (size_t)NTOK * ZLD;
#ifdef PROBE_LM2
                    for (int rep = 0; rep < 2; ++rep)
#endif
                    for (int tl = bx; tl < 256; tl += G)
                        light_mixers_tile(lds, Z, YC, tl, IN(10) + (size_t)l * 16384, IN(11) + l * 256, IN(12) + l * 768, IN(18) + l * 31 * 256, IN(19) + l * 256, IN(20) + l * 256, IN(21) + l * 256, wid);
                    float d1 = 0.f, d2 = 0.f;
                    int lane_l = lane_id(); asm volatile("" : "+v"(lane_l));
                    if (lane_l < 32) { d1 = IN(13)[l * 32 + lane_l] * IN(14)[l * 32 + lane_l]; d2 = IN(15)[l * 32 + lane_l] * IN(16)[l * 32 + lane_l]; }
                    d1 = wave_sum(d1); d2 = wave_sum(d2);
                    const float lam_init = __uint_as_float((unsigned)__builtin_amdgcn_readfirstlane((l == 0) ? (int)0x3e4ccccd : (int)0x3eb60549));
                    const float lam = __uint_as_float((unsigned)__builtin_amdgcn_readfirstlane((int)__float_as_uint(expf(d1) - expf(d2) + lam_init)));
                    const float osc = __uint_as_float((unsigned)__builtin_amdgcn_readfirstlane((int)__float_as_uint(1.0f - lam_init)));
#ifdef PROBE_ATT2
                    for (int rep = 0; rep < 2; ++rep)
#endif
                    for (int pr = bx; pr < 256; pr += G) {
                        const int bh = pr & 7, s = pr >> 3;
                        dattn_unit(lds, VT + (size_t)256 * NTOK, VT, YC, bh >> 2, bh & 3, s, lam, lam_init, IN(17) + l * 64, wid);
                        dattn_unit(lds, VT + (size_t)256 * NTOK, VT, YC, bh >> 2, bh & 3, 63 - s, lam, lam_init, IN(17) + l * 64, wid);
                    }
                }
                GSYNC();
                {
                    pg8::Gemm g = pg8::make_gemm(Yb, Wl + OW_O, NTOK, DM, DM, DM, DM);
                    pg8::StaticOrder S; S.init(NTOK, DM, G, bx);
                    pg8::EpiRes<false> E{XN, IN(23) + l * DM, 1.0f, RSTD, nullptr, SLOTS, PCNT, xk};
                    pg8::gemm_phase<pg8::EpiRes<false>, pg8::StaticOrder, false, true>(lds, g, S, E, wid);
                    xk += 1;
                }
                GSYNC();
                {
                    pg8::Gemm g = pg8::make_gemm(XN, Wl + OW_Q, NTOK, DM, DM, DM, DM);
                    pg8::StaticOrder S; S.init(NTOK, DM, G, bx);
                    pg8::EpiOut E{BIG, DM, 0.09016844005556021f, RSTD, nullptr};
                    pg8::gemm_phase<pg8::EpiOut, pg8::StaticOrder, true, true>(lds, g, S, E, wid);
                }
                LSYNC();
                {
                    pg8::Gemm g = pg8::make_gemm(BIG, KX, NTOK, DM, 256, DM, DM);
                    g.a_pn = 256; g.b_pn = 256; g.b_pb = (long)256 * DM; g.bshift = 5;
                    pg8::StaticOrder S; S.init(NTOK, DM, G, bx);
                    pg8::EpiSoftmax E{BIG + (size_t)NTOK * DM, DM};
                    pg8::gemm_phase<pg8::EpiSoftmax, pg8::StaticOrder, false, true>(lds, g, S, E, wid);
                }
                LSYNC();
                {
                    pg8::Gemm g = pg8::make_gemm(BIG + (size_t)NTOK * DM, VXT, NTOK, DM, 256, DM, 512);
                    g.a_pn = 256; g.b_pn = (long)256 * 512; g.b_pb = 256; g.bshift = 5;
                    pg8::StaticOrder S; S.init(NTOK, DM, G, bx);
                    pg8::EpiOut E{BIG, DM, 1.0f, nullptr, nullptr};
                    pg8::gemm_phase<pg8::EpiOut, pg8::StaticOrder, true, true>(lds, g, S, E, wid);
                }
                GSYNC();
                {
                    pg8::Gemm g = pg8::make_gemm(BIG, Wl + OW_XO, NTOK, DM, DM, DM, DM);
                    pg8::StaticOrder S; S.init(NTOK, DM, G, bx);
                    pg8::EpiRes<false> E{XN, IN(30) + l * DM, 1.0f, RSTD, nullptr, SLOTS, PCNT, xk};
                    pg8::gemm_phase<pg8::EpiRes<false>, pg8::StaticOrder, false, true>(lds, g, S, E, wid);
                    xk += 1;
                }
                GSYNC();
            }
            {
                pg8::Gemm g = pg8::make_gemm(XN, Wl + (ff ? OW_GU2 : OW_GU1), NTOK, 2 * FF, DM, DM, DM);
                pg8::StaticOrder S; S.init(NTOK, 2 * FF, G, bx);
                pg8::EpiSwiGLU E{BIG, FF, RSTD};
                pg8::gemm_phase<pg8::EpiSwiGLU, pg8::StaticOrder, true, true>(lds, g, S, E, wid);
                if (bx >= 128 && !(l == 1 && ff == 1)) {
                    const int slot = (l == 0) ? (ff == 0 ? 1 : 3) : 4;
                    convert_slot(slot, (bx - 128) * 8 + wid, 128 * 8, ptab, Wb, lds, wid);
                }
            }
            GSYNC();
            {
                pg8::Gemm g = pg8::make_gemm(BIG, Wl + (ff ? OW_D2 : OW_D1), NTOK, DM, FF, FF, FF);
                pg8::StaticOrder S; S.init(NTOK, DM, G, bx);
                if (ff == 1 && l == 1) {
                    pg8::EpiRes<true> E{XN, IN(35) + l * DM, 0.5f, RSTD, p.out, SLOTS, PCNT, xk};
                    pg8::gemm_phase<pg8::EpiRes<true>, pg8::StaticOrder, false, true>(lds, g, S, E, wid);
                } else {
                    pg8::EpiRes<false> E{XN, IN(ff ? 35 : 7) + l * DM, 0.5f, RSTD, nullptr, SLOTS, PCNT, xk};
                    pg8::gemm_phase<pg8::EpiRes<false>, pg8::StaticOrder, false, true>(lds, g, S, E, wid);
                    xk += 1;
                }
            }
            if (!(ff == 1 && l == 1)) GSYNC();
        }
    }
}

extern "C" void kernel_launch(void* const* d_in, const int* in_sizes, int n_in, void* d_out, int out_size, void* d_ws, size_t ws_size, hipStream_t stream) {
    static int grid = 0;
    if (grid == 0) {
        if (n_in != 36 || out_size != NTOK * DM || ws_size < WS_END) { fprintf(stderr, "kernel_launch: unexpected problem (n_in %d out %d ws %zu)\n", n_in, out_size, ws_size); grid = -1; return; }
        int dev = 0, cus = 0, per_cu = 0;
        hipGetDevice(&dev);
        hipDeviceGetAttribute(&cus, hipDeviceAttributeMultiprocessorCount, dev);
        if (hipFuncSetAttribute((const void*)mega_fwd, hipFuncAttributeMaxDynamicSharedMemorySize, LDS_BYTES) != hipSuccess) { fprintf(stderr, "kernel_launch: hipFuncSetAttribute failed\n"); grid = -1; return; }
        hipOccupancyMaxActiveBlocksPerMultiprocessor(&per_cu, (const void*)mega_fwd, 512, LDS_BYTES);
        if (per_cu < 1) { fprintf(stderr, "kernel_launch: occupancy query says %d\n", per_cu); per_cu = 1; }
        (void)hipGetLastError();
        grid = cus;
        if (grid != 256) { fprintf(stderr, "kernel_launch: %d CUs (this kernel needs 256)\n", grid); grid = -1; return; }
    }
    if (grid < 0) return;
    if (hipMemsetAsync((char*)d_ws + WS_CTL, 0, 65536, stream) != hipSuccess) { fprintf(stderr, "kernel_launch: memset failed\n"); return; }
    Params p{};
    for (int i = 0; i < 36; ++i) p.in[i] = (const float*)d_in[i];
    p.out = (float*)d_out; p.ws = (unsigned char*)d_ws;
    void* args[] = {&p};
    hipError_t e = hipLaunchCooperativeKernel((const void*)mega_fwd, dim3(grid), dim3(512), args, LDS_BYTES, stream);
    if (e != hipSuccess) fprintf(stderr, "cooperative launch failed: %s (grid %d)\n", hipGetErrorString(e), grid);
}
```

```cpp
#include <hip/hip_runtime.h>
#include <hip/hip_cooperative_groups.h>
#include <cstdio>
#include <cstdint>
#include <cmath>
namespace cg = cooperative_groups;

#define LAS __attribute__((address_space(3)))
typedef unsigned short bf16_t;
typedef short bf16x8 __attribute__((ext_vector_type(8)));
typedef float f32x4 __attribute__((ext_vector_type(4)));
typedef float f32x16 __attribute__((ext_vector_type(16)));
typedef unsigned u32x4 __attribute__((ext_vector_type(4)));
typedef unsigned u32x2 __attribute__((ext_vector_type(2)));

#ifndef USE_CG_SYNC
#define USE_CG_SYNC 1
#endif

constexpr int NTOK = 16384, DM = 1024, FF = 2816, SEQ = 8192, ZLD = 2048;
constexpr float EPS = 1e-6f;
constexpr size_t LW = 24903680;
constexpr size_t OW_GU1 = 0, OW_D1 = 5767168, OW_GU2 = 8650752, OW_D2 = 14417920, OW_IN = 17301504, OW_O = 19660800,
                 OW_Q = 20709376, OW_K = 21757952, OW_V = 22806528, OW_XO = 23855104;
constexpr size_t WS_W = 0, WS_XN = 99614720, WS_BIG = 133169152, WS_Y = 225443840, WS_KV = 258998272, WS_CTL = 263192576, WS_END = 263192576 + 131072 + 524288 + 262144;
constexpr int LDS_BYTES = 147456;
constexpr int ITEMS_PER_LAYER = 6080;

struct Params {
    const float* in[36];
    float* out;
    unsigned char* ws;
};

__device__ __forceinline__ unsigned cvt_pk_bf16(float lo, float hi) { unsigned r; asm volatile("v_cvt_pk_bf16_f32 %0, %1, %2" : "=v"(r) : "v"(lo), "v"(hi)); return r; }
typedef float f32x2_t __attribute__((ext_vector_type(2))); typedef __bf16 bf16x2_t __attribute__((ext_vector_type(2)));
__device__ __forceinline__ unsigned cvtpk_s(float lo, float hi) { f32x2_t v = {lo, hi}; bf16x2_t b = __builtin_convertvector(v, bf16x2_t); return __builtin_bit_cast(unsigned, b); }
__device__ __forceinline__ int lane_id() { int l; asm volatile("v_mbcnt_lo_u32_b32 %0, -1, 0\n\tv_mbcnt_hi_u32_b32 %0, -1, %0" : "=v"(l)); return l; }
__device__ __forceinline__ float bf_lo(unsigned w) { return __uint_as_float(w << 16); }
__device__ __forceinline__ float bf_hi(unsigned w) { return __uint_as_float(w & 0xffff0000u); }
__device__ __forceinline__ float bf2f(bf16_t h) { return __uint_as_float(((unsigned)h) << 16); }
template <int M> __device__ __forceinline__ float shx(float v) {
    static_assert(M < 32, "use sum32 / max32 for the half-wave exchange");
    return __uint_as_float((unsigned)__builtin_amdgcn_ds_swizzle((int)__float_as_uint(v), (M << 10) | 0x1f));
}
__device__ __forceinline__ float sum32(float v) { auto rr = __builtin_amdgcn_permlane32_swap(__float_as_uint(v), __float_as_uint(v), false, false); return __uint_as_float(rr[0]) + __uint_as_float(rr[1]); }
__device__ __forceinline__ float max32(float v) { auto rr = __builtin_amdgcn_permlane32_swap(__float_as_uint(v), __float_as_uint(v), false, false); return fmaxf(__uint_as_float(rr[0]), __uint_as_float(rr[1])); }
__device__ __forceinline__ float wave_sum(float v) {
    v += shx<1>(v); v += shx<2>(v); v += shx<4>(v); v += shx<8>(v); v += shx<16>(v);
    { auto rr = __builtin_amdgcn_permlane32_swap(__float_as_uint(v), __float_as_uint(v), false, false); v = __uint_as_float(rr[0]) + __uint_as_float(rr[1]); }
    return v;
}
__device__ __forceinline__ float fast_exp2(float x) { return __builtin_amdgcn_exp2f(x); }
__device__ __forceinline__ float fast_rcp(float x) { return __builtin_amdgcn_rcpf(x); }
__device__ __forceinline__ float sigmoidf_(float x) { return fast_rcp(1.0f + fast_exp2(-1.4426950408889634f * x)); }
__device__ __forceinline__ void ld8(const bf16_t* p, float (&f)[8]) {
    const u32x4 w = *(const u32x4*)p;
    f[0] = bf_lo(w.x); f[1] = bf_hi(w.x); f[2] = bf_lo(w.y); f[3] = bf_hi(w.y); f[4] = bf_lo(w.z); f[5] = bf_hi(w.z); f[6] = bf_lo(w.w); f[7] = bf_hi(w.w);
}

__device__ __forceinline__ const float* ld_ptr(volatile LAS unsigned long long* tab, int k) {
    const unsigned long long v = tab[k];
    const unsigned lo = __builtin_amdgcn_readfirstlane((unsigned)v), hi = __builtin_amdgcn_readfirstlane((unsigned)(v >> 32));
    return (const float*)(((unsigned long long)hi << 32) | lo);
}

namespace pg8 {
constexpr int BM = 256, BK = 64, HALF = 128, HTB = HALF * BK * 2, STAGE_BYTES = 8 * HTB, NXCD = 8, WGM = 8;
__host__ __device__ __forceinline__ int lds_byte(int r, int c) { const int st = (r >> 4) * 2 + (c >> 5), rr = r & 15, cc = c & 31, ob = rr * 64 + cc * 2; return st * 1024 + (ob ^ (((ob >> 9) & 1) << 5)); }
__host__ __device__ __forceinline__ void stage_rc(int b, int& R, int& C) { const int st = b / 1024, sb = b % 1024, swz = sb ^ (((sb >> 9) & 1) << 5); R = (st >> 1) * 16 + swz / 64; C = (st & 1) * 32 + (swz % 64) / 2; }
__host__ __device__ __forceinline__ int perm32(int rho) { const int n = rho >> 4, i = rho & 15; return 8 * (i >> 2) + 4 * n + (i & 3); }

struct Unit { int pm, pn; };
struct Gemm { const bf16_t* A; const bf16_t* Bt; int M, N, K, lda, ldb; long a_pm, a_pn, b_pn, b_pb; int bshift; };
__device__ __forceinline__ Gemm make_gemm(const bf16_t* A, const bf16_t* Bt, int M, int N, int K, int lda, int ldb) {
    Gemm g; g.A = A; g.Bt = Bt; g.M = M; g.N = N; g.K = K; g.lda = lda; g.ldb = ldb; g.a_pm = (long)BM * lda; g.a_pn = 0; g.b_pn = (long)BM * ldb; g.b_pb = 0; g.bshift = 0; return g;
}

struct StaticOrder {
    int nM, nN, nwg, G, c;
    __device__ void init(int M, int N, int G_, int c_) { nM = M / BM; nN = N / BM; nwg = nM * nN; G = G_; c = c_; }
    __device__ bool next(int i, Unit& u) const {
        const long L = (long)i * G + c; if (L >= nwg) return false;
        int wgid = (int)L; { const int q = nwg / NXCD, r = nwg % NXCD, xcd = wgid % NXCD, off = wgid / NXCD; wgid = (xcd < r ? xcd * (q + 1) : r * (q + 1) + (xcd - r) * q) + off; }
        const int nig = WGM * nN, gid = wgid / nig, fm = gid * WGM, gsz = (nM - fm) < WGM ? (nM - fm) : WGM;
        u.pm = fm + ((wgid % nig) % gsz); u.pn = (wgid % nig) / gsz; return true;
    }
};

__device__ __forceinline__ float rstd_of(const float* pss, int row) { const f32x4 p = *(const f32x4*)(pss + 4 * (size_t)row); return __builtin_amdgcn_rsqf(((p.x + p.y) + (p.z + p.w)) * (1.0f / 1024.0f) + EPS); }
__device__ __forceinline__ float pss_lane(const float* pss, int row, int fq) { return pss[4 * (size_t)row + fq]; }
__device__ __forceinline__ float rstd_fin(float v) { v += shx<16>(v); v = sum32(v); return __builtin_amdgcn_rsqf(v * (1.0f / 1024.0f) + EPS); }
template <int K> __device__ __forceinline__ float bcast16(float v) {
    return __uint_as_float((unsigned)__builtin_amdgcn_ds_swizzle((int)__float_as_uint(v), 0x10 | (K << 5)));
}
template <bool HAS_CS> struct EpiOutT {
    static constexpr bool PERM = true, AFTER_DRAIN = false;
    bf16_t* O; int ldc; float sc; const float* rs; const float* cs;
    __device__ __forceinline__ void operator()(const f32x4 (&acc)[2][2][4][2], const Unit& u, int wr, int wc, int fr, int fq) const {
        const int row0 = u.pm * BM + wr * 64 + fr; const int col0 = u.pn * BM + wc * 32 + 8 * fq;
        f32x4 cv[2][2];
        if constexpr (HAS_CS) {
            const float r = rstd_of(cs, col0 + (fr >> 3) * HALF + (fr & 7));
            cv[0][0] = (f32x4){bcast16<0>(r), bcast16<1>(r), bcast16<2>(r), bcast16<3>(r)};   cv[0][1] = (f32x4){bcast16<4>(r), bcast16<5>(r), bcast16<6>(r), bcast16<7>(r)};
            cv[1][0] = (f32x4){bcast16<8>(r), bcast16<9>(r), bcast16<10>(r), bcast16<11>(r)}; cv[1][1] = (f32x4){bcast16<12>(r), bcast16<13>(r), bcast16<14>(r), bcast16<15>(r)};
        } else {
#pragma unroll
            for (int bj = 0; bj < 2; ++bj)
#pragma unroll
                for (int n = 0; n < 2; ++n) cv[bj][n] = (f32x4){1.f, 1.f, 1.f, 1.f};
        }
        float rsv[2][4];
#pragma unroll
        for (int ai = 0; ai < 2; ++ai)
#pragma unroll
            for (int m = 0; m < 4; ++m) rsv[ai][m] = rs ? pss_lane(rs, row0 + ai * HALF + m * 16, fq) : 0.f;
        if (rs) {
#pragma unroll
            for (int ai = 0; ai < 2; ++ai)
#pragma unroll
                for (int m = 0; m < 4; ++m) rsv[ai][m] = rstd_fin(rsv[ai][m]);
        } else {
#pragma unroll
            for (int ai = 0; ai < 2; ++ai)
#pragma unroll
                for (int m = 0; m < 4; ++m) rsv[ai][m] = 1.0f;
        }
#pragma unroll
        for (int ai = 0; ai < 2; ++ai)
#pragma unroll
            for (int m = 0; m < 4; ++m) { bf16_t* rowp = O + (size_t)(row0 + ai * HALF + m * 16) * ldc + col0;
                const float rsc = rsv[ai][m];
#pragma unroll
                for (int bj = 0; bj < 2; ++bj) { f32x4 v0, v1;
                    if constexpr (HAS_CS) { v0 = acc[ai][bj][m][0] * cv[bj][0] * rsc; v1 = acc[ai][bj][m][1] * cv[bj][1] * rsc; }
                    else { const float s_ = sc * rsc; v0 = acc[ai][bj][m][0] * s_; v1 = acc[ai][bj][m][1] * s_; }
                    u32x4 w; w.x = cvt_pk_bf16(v0[0], v0[1]); w.y = cvt_pk_bf16(v0[2], v0[3]); w.z = cvt_pk_bf16(v1[0], v1[1]); w.w = cvt_pk_bf16(v1[2], v1[3]);
                    *(u32x4*)(rowp + bj * HALF) = w; } }
    }
};
typedef EpiOutT<false> EpiOut; typedef EpiOutT<true> EpiOutCS;
struct EpiSwiGLU {
    static constexpr bool PERM = true, AFTER_DRAIN = false;
    bf16_t* O; int ldc; const float* rs;
    __device__ __forceinline__ void operator()(const f32x4 (&acc)[2][2][4][2], const Unit& u, int wr, int wc, int fr, int fq) const {
        const int row0 = u.pm * BM + wr * 64 + fr; const int col0 = u.pn * HALF + wc * 32 + 8 * fq;
        float rsv[2][4];
#pragma unroll
        for (int ai = 0; ai < 2; ++ai)
#pragma unroll
            for (int m = 0; m < 4; ++m) rsv[ai][m] = pss_lane(rs, row0 + ai * HALF + m * 16, fq);
#pragma unroll
        for (int ai = 0; ai < 2; ++ai)
#pragma unroll
            for (int m = 0; m < 4; ++m) rsv[ai][m] = rstd_fin(rsv[ai][m]);
#pragma unroll
        for (int ai = 0; ai < 2; ++ai)
#pragma unroll
            for (int m = 0; m < 4; ++m) { bf16_t* rowp = O + (size_t)(row0 + ai * HALF + m * 16) * ldc + col0;
                const float rsc = rsv[ai][m];
                float h[8], gg[8], uu[8], ee[8];
#pragma unroll
                for (int q = 0; q < 8; ++q) { gg[q] = acc[ai][0][m][q >> 2][q & 3] * rsc; uu[q] = acc[ai][1][m][q >> 2][q & 3] * rsc; }
#pragma unroll
                for (int q = 0; q < 8; ++q) ee[q] = fast_exp2(-1.4426950408889634f * gg[q]);
#pragma unroll
                for (int q = 0; q < 8; ++q) uu[q] *= gg[q];
#pragma unroll
                for (int q = 0; q < 8; ++q) ee[q] = fast_rcp(1.0f + ee[q]);
#pragma unroll
                for (int q = 0; q < 8; ++q) h[q] = uu[q] * ee[q];
                u32x4 w; w.x = cvt_pk_bf16(h[0], h[1]); w.y = cvt_pk_bf16(h[2], h[3]); w.z = cvt_pk_bf16(h[4], h[5]); w.w = cvt_pk_bf16(h[6], h[7]);
                *(u32x4*)rowp = w; }
    }
};
struct EpiWin {
    static constexpr bool PERM = true, AFTER_DRAIN = false;
    bf16_t* O; int ldc; const int* pos; float qscale; const float* rs; bf16_t* QC;
    __device__ __forceinline__ void operator()(f32x4 (&acc)[2][2][4][2], const Unit& u, int wr, int wc, int fr, int fq) const {
        const int row0 = u.pm * BM + wr * 64 + fr; const int col0 = u.pn * BM + wc * 32 + 8 * fq;
        const bool rope = (u.pn == 4 || u.pn == 5);
        const float sc = (u.pn == 4) ? qscale : 1.0f;
        float rsv[2][4];
#pragma unroll
        for (int ai = 0; ai < 2; ++ai)
#pragma unroll
            for (int m = 0; m < 4; ++m) rsv[ai][m] = pss_lane(rs, row0 + ai * HALF + m * 16, fq);
#pragma unroll
        for (int ai = 0; ai < 2; ++ai)
#pragma unroll
            for (int m = 0; m < 4; ++m) rsv[ai][m] = sc * rstd_fin(rsv[ai][m]);
        if (rope && fq == 0) {
            int posv[2][4];
#pragma unroll
            for (int ai = 0; ai < 2; ++ai)
#pragma unroll
                for (int m = 0; m < 4; ++m) posv[ai][m] = pos[row0 + ai * HALF + m * 16];
#pragma unroll
            for (int ai = 0; ai < 2; ++ai)
#pragma unroll
                for (int m = 0; m < 4; ++m) {
                    const float p = (float)posv[ai][m];
                    const float invf[4] = {1.0f, 0.03760603093086394f, 0.0014142135623730951f, 5.318295896944989e-05f};
                    float cs[4], sn[4];
#pragma unroll
                    for (int i = 0; i < 4; ++i) { const float ang = p * invf[i];
                        const float fr_ = __builtin_amdgcn_fractf(ang * 0.15915494309189535f);
                        sn[i] = __builtin_amdgcn_sinf(fr_); cs[i] = __builtin_amdgcn_cosf(fr_); }
#pragma unroll
                    for (int bj = 0; bj < 2; ++bj) { const f32x4 x1 = acc[ai][bj][m][0], x2 = acc[ai][bj][m][1];
#pragma unroll
                        for (int i = 0; i < 4; ++i) { acc[ai][bj][m][0][i] = x1[i] * cs[i] - x2[i] * sn[i]; acc[ai][bj][m][1][i] = x2[i] * cs[i] + x1[i] * sn[i]; } }
                }
        }
#pragma unroll
        for (int ai = 0; ai < 2; ++ai)
#pragma unroll
            for (int m = 0; m < 4; ++m) { const int row = row0 + ai * HALF + m * 16; bf16_t* rowp = O + (size_t)row * ldc + col0;
                const float rsc = rsv[ai][m];
                bf16_t* cp = QC + (rope ? (size_t)(u.pn - 4) * 8 * 8192 * 64 : 0) + ((size_t)((row >> 13) * 4 + (wc >> 1)) * 8192 + (row & 8191)) * 64 + (wc & 1) * 32 + 8 * fq;
#pragma unroll
                for (int bj = 0; bj < 2; ++bj) { const f32x4 v0 = acc[ai][bj][m][0] * rsc, v1 = acc[ai][bj][m][1] * rsc;
                    u32x4 w; w.x = cvt_pk_bf16(v0[0], v0[1]); w.y = cvt_pk_bf16(v0[2], v0[3]); w.z = cvt_pk_bf16(v1[0], v1[1]); w.w = cvt_pk_bf16(v1[2], v1[3]);
                    if (rope) *(u32x4*)(cp + (size_t)bj * 2 * 8192 * 64) = w; else *(u32x4*)(rowp + bj * HALF) = w; } }
    }
};
struct EpiSoftmax {
    static constexpr bool PERM = true, AFTER_DRAIN = true;
    bf16_t* O; int ldc;
    __device__ __forceinline__ void fused(f32x4 (&acc)[2][2][4][2], const Unit& u, int wr, int wc, int fr, int fq, LAS unsigned char* lds, int wid, int lane) const {
        LAS float* Pm = (LAS float*)lds; LAS float* Ps = (LAS float*)(lds + 4096);
#pragma unroll
        for (int ai = 0; ai < 2; ++ai)
#pragma unroll
            for (int m = 0; m < 4; ++m) { float v = -INFINITY;
#pragma unroll
                for (int bj = 0; bj < 2; ++bj)
#pragma unroll
                    for (int n = 0; n < 2; ++n) { const f32x4 x = acc[ai][bj][m][n]; v = fmaxf(v, fmaxf(fmaxf(x[0], x[1]), fmaxf(x[2], x[3]))); }
                v = fmaxf(v, shx<16>(v)); v = max32(v);
                if (fq == 0) Pm[(ai * HALF + wr * 64 + m * 16 + fr) * 4 + wc] = v; }
        __syncthreads();
#pragma unroll
        for (int ai = 0; ai < 2; ++ai)
#pragma unroll
            for (int m = 0; m < 4; ++m) { const int row = ai * HALF + wr * 64 + m * 16 + fr; const f32x4 t = *(const LAS f32x4*)(Pm + row * 4);
                const float mx = fmaxf(fmaxf(t[0], t[1]), fmaxf(t[2], t[3])); float s = 0.f;
#pragma unroll
                for (int bj = 0; bj < 2; ++bj)
#pragma unroll
                    for (int n = 0; n < 2; ++n)
#pragma unroll
                        for (int j = 0; j < 4; ++j) acc[ai][bj][m][n][j] = fast_exp2(acc[ai][bj][m][n][j] - mx);
#pragma unroll
                for (int bj = 0; bj < 2; ++bj)
#pragma unroll
                    for (int n = 0; n < 2; ++n) { const f32x4 x = acc[ai][bj][m][n]; s += (x[0] + x[1]) + (x[2] + x[3]); }
                {
                s += shx<16>(s); s = sum32(s);
                if (fq == 0) Ps[row * 4 + wc] = s; } }
        __syncthreads();
        const int col0 = u.pn * BM + wc * 32 + 8 * fq;
#pragma unroll
        for (int ai = 0; ai < 2; ++ai)
#pragma unroll
            for (int m = 0; m < 4; ++m) { const int row = ai * HALF + wr * 64 + m * 16 + fr; const f32x4 t = *(const LAS f32x4*)(Ps + row * 4);
                const float inv = 1.0f / ((t[0] + t[1]) + (t[2] + t[3]));
                bf16_t* rowp = O + (size_t)(u.pm * BM + row) * ldc + col0;
#pragma unroll
                for (int bj = 0; bj < 2; ++bj) { const f32x4 v0 = acc[ai][bj][m][0] * inv, v1 = acc[ai][bj][m][1] * inv;
                    u32x4 w; w.x = cvt_pk_bf16(v0[0], v0[1]); w.y = cvt_pk_bf16(v0[2], v0[3]); w.z = cvt_pk_bf16(v1[0], v1[1]); w.w = cvt_pk_bf16(v1[2], v1[3]);
                    *(u32x4*)(rowp + bj * HALF) = w; } }
        __syncthreads();
    }
};


__device__ __forceinline__ void panel_exchange(const float (&part)[2][4], float* slotbuf, unsigned* cntw, unsigned want, int pm, int pn, int wr, int wc, int fr, int fq, LAS unsigned char* lds, int wid, int lane) {
    LAS float* P = (LAS float*)lds; LAS float* S = (LAS float*)(lds + 8192);
    if (fq == 0) {
#pragma unroll
        for (int ai = 0; ai < 2; ++ai)
#pragma unroll
            for (int m = 0; m < 4; ++m) P[(ai * HALF + wr * 64 + m * 16 + fr) * 4 + wc] = part[ai][m];
    }
    __syncthreads();
    const int tid = wid * 64 + lane;
    if (tid < 256) { const f32x4 t = *(const LAS f32x4*)(P + tid * 4);
        __hip_atomic_store(slotbuf + ((size_t)(pm * BM + tid)) * 4 + pn, (t.x + t.y) + (t.z + t.w), __ATOMIC_RELAXED, __HIP_MEMORY_SCOPE_AGENT); }
    asm volatile("s_waitcnt vmcnt(0)" ::: "memory");
    if (wid < 4 && lane == 0) __hip_atomic_fetch_add(cntw, 1u, __ATOMIC_RELAXED, __HIP_MEMORY_SCOPE_AGENT);
    if (wid == 0) {
        unsigned sp = 0;
        while ((unsigned)__builtin_amdgcn_readfirstlane(__hip_atomic_load(cntw, __ATOMIC_RELAXED, __HIP_MEMORY_SCOPE_AGENT)) < want) { __builtin_amdgcn_s_sleep(2); if (++sp > (1u << 22)) break; }
    }
    asm volatile("s_waitcnt vmcnt(0) lgkmcnt(0)" ::: "memory"); __syncthreads();
    if (tid < 256) { const float* sl = slotbuf + ((size_t)(pm * BM + tid)) * 4;
        f32x4 q; asm volatile("global_load_dwordx4 %0, %1, off sc1\n\ts_waitcnt vmcnt(0)" : "=&v"(q) : "v"(sl) : "memory");
        S[tid] = (q.x + q.y) + (q.z + q.w); }
    __syncthreads();
}
template <bool FINAL> struct EpiRes {
    static constexpr bool PERM = true, AFTER_DRAIN = true;
    bf16_t* XB; const float* gpost; float wgt; float* rstd; float* outf; float* slots; unsigned* cnt; unsigned xk;
    __device__ __forceinline__ void fused(f32x4 (&acc)[2][2][4][2], const Unit& u, int wr, int wc, int fr, int fq, LAS unsigned char* lds, int wid, int lane) const {
        const LAS float* S = (const LAS float*)(lds + 8192);
        const int col0 = u.pn * BM + wc * 32 + 8 * fq;
        u32x4 xres[2][4][2]; f32x4 gv[2][2];
#pragma unroll
        for (int ai = 0; ai < 2; ++ai)
#pragma unroll
            for (int m = 0; m < 4; ++m)
#pragma unroll
                for (int bj = 0; bj < 2; ++bj) xres[ai][m][bj] = *(const u32x4*)(XB + (size_t)(u.pm * BM + ai * HALF + wr * 64 + m * 16 + fr) * 1024 + col0 + bj * HALF);
#pragma unroll
        for (int bj = 0; bj < 2; ++bj)
#pragma unroll
            for (int n = 0; n < 2; ++n) gv[bj][n] = *(const f32x4*)(gpost + col0 + bj * HALF + 4 * n);
        float part[2][4];
#pragma unroll
        for (int ai = 0; ai < 2; ++ai)
#pragma unroll
            for (int m = 0; m < 4; ++m) { float s = 0.f;
#pragma unroll
                for (int bj = 0; bj < 2; ++bj)
#pragma unroll
                    for (int n = 0; n < 2; ++n) { const f32x4 x = acc[ai][bj][m][n]; s += (x[0] * x[0] + x[1] * x[1]) + (x[2] * x[2] + x[3] * x[3]); }
                s += shx<16>(s); s = sum32(s); part[ai][m] = s; }
        panel_exchange(part, slots + (size_t)(xk & 1u) * 65536, cnt + 64 * u.pm, 16u * (xk + 1u), u.pm, u.pn, wr, wc, fr, fq, lds, wid, lane);
#pragma unroll
        for (int ai = 0; ai < 2; ++ai)
#pragma unroll
            for (int m = 0; m < 4; ++m) { const int row = ai * HALF + wr * 64 + m * 16 + fr; const float rs = wgt * __builtin_amdgcn_rsqf(S[row] * (1.0f / 1024.0f) + EPS);
                bf16_t* xp = XB + (size_t)(u.pm * BM + row) * 1024 + col0; float s2 = 0.f;
#pragma unroll
                for (int bj = 0; bj < 2; ++bj) { const u32x4 xw = xres[ai][m][bj];
                    const f32x4 x0 = (f32x4){bf_lo(xw.x), bf_hi(xw.x), bf_lo(xw.y), bf_hi(xw.y)}, x1 = (f32x4){bf_lo(xw.z), bf_hi(xw.z), bf_lo(xw.w), bf_hi(xw.w)};
                    const f32x4 v0 = x0 + acc[ai][bj][m][0] * gv[bj][0] * rs, v1 = x1 + acc[ai][bj][m][1] * gv[bj][1] * rs;
                    if constexpr (FINAL) { float* op = outf + (size_t)(u.pm * BM + row) * 1024 + col0 + bj * HALF; *(f32x4*)op = v0; *(f32x4*)(op + 4) = v1; }
                    else { u32x4 w; w.x = cvt_pk_bf16(v0[0], v0[1]); w.y = cvt_pk_bf16(v0[2], v0[3]); w.z = cvt_pk_bf16(v1[0], v1[1]); w.w = cvt_pk_bf16(v1[2], v1[3]);
                        *(u32x4*)(xp + bj * HALF) = w;
                        const float a0 = bf_lo(w.x), a1 = bf_hi(w.x), a2 = bf_lo(w.y), a3 = bf_hi(w.y), a4 = bf_lo(w.z), a5 = bf_hi(w.z), a6 = bf_lo(w.w), a7 = bf_hi(w.w);
                        s2 += ((a0 * a0 + a1 * a1) + (a2 * a2 + a3 * a3)) + ((a4 * a4 + a5 * a5) + (a6 * a6 + a7 * a7)); } }
                if constexpr (!FINAL) { s2 += shx<16>(s2); s2 = sum32(s2); part[ai][m] = s2; } }
        if constexpr (!FINAL) {
            LAS float* P = (LAS float*)lds;
            if (fq == 0) {
#pragma unroll
                for (int ai = 0; ai < 2; ++ai)
#pragma unroll
                    for (int m = 0; m < 4; ++m) P[(ai * HALF + wr * 64 + m * 16 + fr) * 4 + wc] = part[ai][m];
            }
            __syncthreads();
            const int tid = wid * 64 + lane;
            if (tid < 256) { const f32x4 t = *(const LAS f32x4*)(P + tid * 4); rstd[((size_t)(u.pm * BM + tid)) * 4 + u.pn] = (t.x + t.y) + (t.z + t.w); }
            __syncthreads();
        }
    }
};

template <class Epi, class Sched, bool ALIGN_EPI = false, bool SP2 = false>
__device__ __forceinline__ void gemm_phase(LAS unsigned char* lds, const Gemm g, const Sched S, const Epi E, int wid0) {
    int tid = wid0 * 64 + lane_id(); asm volatile("" : "+v"(tid));
    const int wid = __builtin_amdgcn_readfirstlane(tid >> 6), lane = tid & 63, wr = wid >> 2, wc = wid & 3, fr = lane & 15, fq = lane >> 4;
    const int K = g.K, nt = K / BK;
    unsigned voffA[2], voffB[2];
#pragma unroll
    for (int i = 0; i < 2; ++i) { int R, C; stage_rc(tid * 16 + i * 8192, R, C); const int Rb = Epi::PERM ? ((R & ~31) + perm32(R & 31)) : R;
        voffA[i] = (unsigned)(R * g.lda + C) * 2u; voffB[i] = (unsigned)(Rb * g.ldb + C) * 2u; }
    const size_t kstep = (size_t)(BK * 2);
    const size_t hstepA = (size_t)HALF * g.lda * 2, hstepB = (size_t)HALF * g.ldb * 2;
    const unsigned ldsw = (unsigned)wid * 1024u;
    const int aoff = lds_byte(wr * 64 + fr, fq * 8), boff = lds_byte(wc * 32 + fr, fq * 8);
#define PG8_UA(u) ((const char*)g.A + 2 * ((long)(u).pm * g.a_pm + (long)(u).pn * g.a_pn))
#define PG8_UB(u) ((const char*)g.Bt + 2 * ((long)(u).pn * g.b_pn + (long)((u).pm >> g.bshift) * g.b_pb))
#define PG8_SA(b, h) (((b) * 2 + (h)) * HTB)
#define PG8_SB(b, h) ((4 + (b) * 2 + (h)) * HTB)
#define PG8_STAGE(bufoff, gbase, voff) do { _Pragma("unroll") for (int _i = 0; _i < 2; ++_i) \
        __builtin_amdgcn_global_load_lds((const unsigned*)((const char*)(gbase) + (voff)[_i]), (LAS unsigned*)(lds + (bufoff) + ldsw + _i * 8192), 16, 0, 0); } while (0)
#define PG8_LDA(dst, b, h) do { _Pragma("unroll") for (int m = 0; m < 4; ++m) _Pragma("unroll") for (int k = 0; k < 2; ++k) dst[m][k] = *(const LAS bf16x8*)(lds + PG8_SA(b, h) + aoff + m * 2048 + k * 1024); } while (0)
#define PG8_LDB(dst, b, h) do { _Pragma("unroll") for (int n = 0; n < 2; ++n) _Pragma("unroll") for (int k = 0; k < 2; ++k) dst[n][k] = *(const LAS bf16x8*)(lds + PG8_SB(b, h) + boff + n * 2048 + k * 1024); } while (0)
#define PG8_MMA(ai, bj, At, Bt) do { __builtin_amdgcn_s_setprio(1); _Pragma("unroll") for (int m = 0; m < 4; ++m) _Pragma("unroll") for (int n = 0; n < 2; ++n) _Pragma("unroll") for (int k = 0; k < 2; ++k) \
        acc[ai][bj][m][n] = __builtin_amdgcn_mfma_f32_16x16x32_bf16(Bt[n][k], At[m][k], acc[ai][bj][m][n], 0, 0, 0); __builtin_amdgcn_s_setprio(0); } while (0)
#define PG8_WAIT_V(n) asm volatile("s_waitcnt vmcnt(" #n ")" ::: "memory")
#define PG8_WAIT_L(n) asm volatile("s_waitcnt lgkmcnt(" #n ")" ::: "memory")
#define PG8_BAR __builtin_amdgcn_s_barrier()
#define PG8_SCHED __builtin_amdgcn_sched_barrier(0)
    Unit cur, nxt; int ui = 0;
    if (!S.next(0, cur)) return;
    f32x4 acc[2][2][4][2];
#pragma unroll
    for (int a = 0; a < 2; ++a)
#pragma unroll
        for (int b = 0; b < 2; ++b)
#pragma unroll
            for (int m = 0; m < 4; ++m)
#pragma unroll
                for (int n = 0; n < 2; ++n) acc[a][b][m][n] = (f32x4){0.f, 0.f, 0.f, 0.f};
    bf16x8 At[4][2], B0[2][2], B1[2][2];
    const char* cA = PG8_UA(cur); const char* cB = PG8_UB(cur);
    if constexpr (SP2) {
        PG8_STAGE(PG8_SB(0, 0), cB, voffB); PG8_STAGE(PG8_SB(0, 1), cB + hstepB, voffB); PG8_STAGE(PG8_SA(0, 0), cA, voffA); PG8_STAGE(PG8_SA(0, 1), cA + hstepA, voffA);
        if (wr == 1) PG8_BAR;
        PG8_WAIT_V(2); PG8_BAR;
        PG8_STAGE(PG8_SB(1, 0), cB + kstep, voffB); PG8_STAGE(PG8_SA(1, 0), cA + kstep, voffA); PG8_STAGE(PG8_SB(1, 1), cB + hstepB + kstep, voffB);
        PG8_WAIT_V(6); PG8_BAR;
    } else {
        PG8_STAGE(PG8_SB(0, 0), cB, voffB); PG8_STAGE(PG8_SA(0, 0), cA, voffA); PG8_STAGE(PG8_SB(0, 1), cB + hstepB, voffB); PG8_STAGE(PG8_SA(0, 1), cA + hstepA, voffA);
        if (wr == 1) PG8_BAR;
        PG8_WAIT_V(4); PG8_BAR;
        PG8_STAGE(PG8_SB(1, 0), cB + kstep, voffB); PG8_STAGE(PG8_SA(1, 0), cA + kstep, voffA); PG8_STAGE(PG8_SB(1, 1), cB + hstepB + kstep, voffB);
        PG8_WAIT_V(6); PG8_BAR;
    }
    for (;;) {
        const bool has_next = S.next(ui + 1, nxt);
        const char* nA = has_next ? PG8_UA(nxt) : cA; const char* nB = has_next ? PG8_UB(nxt) : cB;
        for (int t = 0; t < nt; t += 2) {
            const bool last = (t == nt - 2);
            const char* a1 = cA + (size_t)(t + 1) * kstep;
            const char* a2 = last ? nA : cA + (size_t)(t + 2) * kstep; const char* b2 = last ? nB : cB + (size_t)(t + 2) * kstep;
            const char* a3 = a2 + kstep; const char* b3 = b2 + kstep;
            if constexpr (SP2) {
            PG8_LDB(B0, 0, 0); PG8_LDB(B1, 0, 1); PG8_SCHED; PG8_LDA(At, 0, 0); PG8_STAGE(PG8_SA(1, 1), a1 + hstepA, voffA);
            PG8_WAIT_V(8); PG8_WAIT_L(0); PG8_BAR; PG8_MMA(0, 0, At, B0); PG8_MMA(0, 1, At, B1); PG8_BAR; PG8_SCHED;
            PG8_LDA(At, 0, 1); PG8_STAGE(PG8_SB(0, 0), b2, voffB); PG8_STAGE(PG8_SB(0, 1), b2 + hstepB, voffB); PG8_STAGE(PG8_SA(0, 0), a2, voffA);
            PG8_WAIT_V(8); PG8_WAIT_L(0); PG8_BAR; PG8_MMA(1, 0, At, B0); PG8_MMA(1, 1, At, B1); PG8_BAR; PG8_SCHED;
            PG8_LDB(B0, 1, 0); PG8_LDB(B1, 1, 1); PG8_SCHED; PG8_LDA(At, 1, 0); PG8_STAGE(PG8_SA(0, 1), a2 + hstepA, voffA);
            PG8_WAIT_V(8); PG8_WAIT_L(0); PG8_BAR; PG8_MMA(0, 0, At, B0); PG8_MMA(0, 1, At, B1); PG8_BAR; PG8_SCHED;
            PG8_LDA(At, 1, 1); PG8_STAGE(PG8_SB(1, 0), b3, voffB); PG8_STAGE(PG8_SB(1, 1), b3 + hstepB, voffB); PG8_STAGE(PG8_SA(1, 0), a3, voffA);
            PG8_WAIT_V(8); PG8_WAIT_L(0); PG8_BAR; PG8_MMA(1, 0, At, B0); PG8_MMA(1, 1, At, B1); PG8_BAR; PG8_SCHED;
            } else {
            PG8_LDB(B0, 0, 0); PG8_SCHED; PG8_LDA(At, 0, 0); PG8_STAGE(PG8_SA(1, 1), a1 + hstepA, voffA);
            PG8_WAIT_L(8); PG8_BAR; PG8_WAIT_L(0); PG8_MMA(0, 0, At, B0); PG8_BAR; PG8_SCHED;
            PG8_LDB(B1, 0, 1); PG8_STAGE(PG8_SB(0, 0), b2, voffB);
            PG8_BAR; PG8_WAIT_L(0); PG8_MMA(0, 1, At, B1); PG8_BAR;
            PG8_LDA(At, 0, 1); PG8_STAGE(PG8_SA(0, 0), a2, voffA);
            PG8_BAR; PG8_WAIT_L(0); PG8_MMA(1, 0, At, B0); PG8_BAR; PG8_SCHED;
            PG8_STAGE(PG8_SB(0, 1), b2 + hstepB, voffB);
            PG8_WAIT_V(6); PG8_BAR; PG8_MMA(1, 1, At, B1); PG8_BAR;
            PG8_LDB(B0, 1, 0); PG8_SCHED; PG8_LDA(At, 1, 0); PG8_STAGE(PG8_SA(0, 1), a2 + hstepA, voffA);
            PG8_WAIT_L(8); PG8_BAR; PG8_WAIT_L(0); PG8_MMA(0, 0, At, B0); PG8_BAR; PG8_SCHED;
            PG8_LDB(B1, 1, 1); PG8_STAGE(PG8_SB(1, 0), b3, voffB);
            PG8_BAR; PG8_WAIT_L(0); PG8_MMA(0, 1, At, B1); PG8_BAR;
            PG8_LDA(At, 1, 1); PG8_STAGE(PG8_SA(1, 0), a3, voffA);
            PG8_BAR; PG8_WAIT_L(0); PG8_MMA(1, 0, At, B0); PG8_BAR; PG8_SCHED;
            PG8_STAGE(PG8_SB(1, 1), b3 + hstepB, voffB);
            PG8_WAIT_V(6); PG8_BAR; PG8_MMA(1, 1, At, B1); PG8_BAR;
            }
        }
        if constexpr (ALIGN_EPI) { if (wr == 0) PG8_BAR; }
        if constexpr (!Epi::AFTER_DRAIN) { E(acc, cur, wr, wc, fr, fq); }
        if (!has_next) break;
#pragma unroll
        for (int a = 0; a < 2; ++a)
#pragma unroll
            for (int b = 0; b < 2; ++b)
#pragma unroll
                for (int m = 0; m < 4; ++m)
#pragma unroll
                    for (int n = 0; n < 2; ++n) acc[a][b][m][n] = (f32x4){0.f, 0.f, 0.f, 0.f};
        cur = nxt; cA = nA; cB = nB; ++ui;
        if constexpr (ALIGN_EPI) { if (wr == 1) PG8_BAR; }
    }
    PG8_WAIT_V(0);
    if constexpr (!ALIGN_EPI) { if (wr == 0) PG8_BAR; }
    PG8_BAR;
    if constexpr (Epi::AFTER_DRAIN) { E.fused(acc, cur, wr, wc, fr, fq, lds, wid, lane); }
#undef PG8_UA
#undef PG8_UB
#undef PG8_SA
#undef PG8_SB
#undef PG8_STAGE
#undef PG8_LDA
#undef PG8_LDB
#undef PG8_MMA
#undef PG8_WAIT_V
#undef PG8_WAIT_L
#undef PG8_BAR
#undef PG8_SCHED
}
}

struct TItem { const float* W; bf16_t* WT; const float* gk; int K, N, drow0, k0, n0; bool valid; };
__device__ __forceinline__ void ti_load(const TItem& t, f32x4 (&v)[16], int lane) {
    const int lr = lane >> 4, lc = (lane & 15) * 4;
    if (t.valid) {
#pragma unroll
        for (int i = 0; i < 16; ++i) v[i] = *(const f32x4*)(t.W + (size_t)(t.k0 + 4 * i + lr) * t.N + t.n0 + lc);
    }
}
__device__ __forceinline__ void ti_finish(const TItem& t, f32x4 (&v)[16], LAS float* scr, int lane) {
    if (!t.valid) return;
    const int lr = lane >> 4, lc = (lane & 15) * 4;
    const int c = lane & 7;
    f32x4 g0 = (f32x4){1.f, 1.f, 1.f, 1.f}, g1 = g0;
    if (t.gk) { g0 = *(const f32x4*)(t.gk + t.k0 + 8 * c); g1 = *(const f32x4*)(t.gk + t.k0 + 8 * c + 4); }
#pragma unroll
    for (int i = 0; i < 16; ++i) { LAS float* s = scr + (4 * i + lr) * 65 + lc; s[0] = v[i].x; s[1] = v[i].y; s[2] = v[i].z; s[3] = v[i].w; }
    asm volatile("s_waitcnt lgkmcnt(0)" ::: "memory");
#pragma unroll
    for (int j = 0; j < 8; ++j) { const int n = (lane >> 3) + 8 * j; const LAS float* s = scr + (8 * c) * 65 + n;
        u32x4 o; o.x = cvt_pk_bf16(s[0 * 65] * g0.x, s[1 * 65] * g0.y); o.y = cvt_pk_bf16(s[2 * 65] * g0.z, s[3 * 65] * g0.w); o.z = cvt_pk_bf16(s[4 * 65] * g1.x, s[5 * 65] * g1.y); o.w = cvt_pk_bf16(s[6 * 65] * g1.z, s[7 * 65] * g1.w);
        *(u32x4*)(t.WT + (size_t)(t.drow0 + n) * t.K + t.k0 + 8 * c) = o; }
    asm volatile("s_waitcnt lgkmcnt(0)" ::: "memory");
}

template <bool HAS_Y, bool HAS_XN>
__device__ __forceinline__ void rowpass(const float* xin, float* xout, const bf16_t* Y, const float* gpost, float wgt, bf16_t* XN, const float* gpre, int nrows, int gw, int NGW, int lane_in) {
    int lane = lane_in; asm volatile("" : "+v"(lane));
    for (int m = gw; m < nrows; m += NGW) {
        const f32x4* xr = (const f32x4*)(xin + (size_t)m * DM) + lane;
        f32x4 v[4];
#pragma unroll
        for (int j = 0; j < 4; ++j) v[j] = xr[64 * j];
        if constexpr (HAS_Y) {
            const u32x2* yr = (const u32x2*)(Y + (size_t)m * DM) + lane;
            f32x4 y[4]; float ss = 0.f;
#pragma unroll
            for (int j = 0; j < 4; ++j) { const u32x2 w = yr[64 * j]; y[j] = (f32x4){bf_lo(w.x), bf_hi(w.x), bf_lo(w.y), bf_hi(w.y)};
                ss += (y[j].x * y[j].x + y[j].y * y[j].y) + (y[j].z * y[j].z + y[j].w * y[j].w); }
            ss = wave_sum(ss);
            const float rs = wgt / sqrtf(ss * (1.0f / DM) + EPS);
#pragma unroll
            for (int j = 0; j < 4; ++j) { const f32x4 g = ((const f32x4*)gpost)[lane + 64 * j]; v[j] = v[j] + y[j] * g * rs; }
        }
        if (xout) { f32x4* xo = (f32x4*)(xout + (size_t)m * DM) + lane;
#pragma unroll
            for (int j = 0; j < 4; ++j) xo[64 * j] = v[j]; }
        if constexpr (HAS_XN) {
            float s2 = 0.f;
#pragma unroll
            for (int j = 0; j < 4; ++j) s2 += (v[j].x * v[j].x + v[j].y * v[j].y) + (v[j].z * v[j].z + v[j].w * v[j].w);
            s2 = wave_sum(s2);
            const float rs2 = 1.0f / sqrtf(s2 * (1.0f / DM) + EPS);
            u32x2* xo = (u32x2*)(XN + (size_t)m * DM) + lane;
#pragma unroll
            for (int j = 0; j < 4; ++j) { const f32x4 g = ((const f32x4*)gpre)[lane + 64 * j]; const f32x4 o = v[j] * g * rs2;
                u32x2 w; w.x = cvt_pk_bf16(o.x, o.y); w.y = cvt_pk_bf16(o.z, o.w); xo[64 * j] = w; }
        }
    }
}

__device__ __forceinline__ void rowpass0(const float* xin, bf16_t* XB, float* rstd, int gw, int NGW, int lane_in) {
    int lane = lane_in; asm volatile("" : "+v"(lane));
    for (int m = gw; m < NTOK; m += 2 * NGW) {
        const int m2 = m + NGW;
        const f32x4* xr = (const f32x4*)(xin + (size_t)m * DM) + lane; const f32x4* xr2 = (const f32x4*)(xin + (size_t)m2 * DM) + lane;
        f32x4 va[4], vb[4];
#pragma unroll
        for (int j = 0; j < 4; ++j) { va[j] = xr[64 * j]; vb[j] = xr2[64 * j]; }
        u32x2* xo = (u32x2*)(XB + (size_t)m * DM) + lane; u32x2* xo2 = (u32x2*)(XB + (size_t)m2 * DM) + lane;
        float s2 = 0.f, t2 = 0.f;
#pragma unroll
        for (int j = 0; j < 4; ++j) {
            u32x2 w; w.x = cvt_pk_bf16(va[j].x, va[j].y); w.y = cvt_pk_bf16(va[j].z, va[j].w); xo[64 * j] = w;
            { const float a = bf_lo(w.x), b = bf_hi(w.x), c = bf_lo(w.y), d = bf_hi(w.y); s2 += (a * a + b * b) + (c * c + d * d); }
            u32x2 w2; w2.x = cvt_pk_bf16(vb[j].x, vb[j].y); w2.y = cvt_pk_bf16(vb[j].z, vb[j].w); xo2[64 * j] = w2;
            { const float a = bf_lo(w2.x), b = bf_hi(w2.x), c = bf_lo(w2.y), d = bf_hi(w2.y); t2 += (a * a + b * b) + (c * c + d * d); }
        }
        s2 = wave_sum(s2); t2 = wave_sum(t2);
        if (lane == 0) { *(f32x4*)(rstd + 4 * (size_t)m) = (f32x4){s2, 0.f, 0.f, 0.f}; *(f32x4*)(rstd + 4 * (size_t)m2) = (f32x4){t2, 0.f, 0.f, 0.f}; }
    }
}
__device__ __forceinline__ void wave_sum8(float (&v)[8]) {
#pragma unroll
    for (int i = 0; i < 8; ++i) v[i] += shx<1>(v[i]);
#pragma unroll
    for (int i = 0; i < 8; ++i) v[i] += shx<2>(v[i]);
#pragma unroll
    for (int i = 0; i < 8; ++i) v[i] += shx<4>(v[i]);
#pragma unroll
    for (int i = 0; i < 8; ++i) v[i] += shx<8>(v[i]);
#pragma unroll
    for (int i = 0; i < 8; ++i) v[i] += shx<16>(v[i]);
#pragma unroll
    for (int i = 0; i < 8; ++i) v[i] = sum32(v[i]);
}
__device__ __forceinline__ void light_mixers_tile(LAS unsigned char* lds, const bf16_t* Z, bf16_t* YC, int tl, const float* pool_w, const float* pool_scale, const float* sconv_w,
                                                  const float* dw_w, const float* dw_b, const float* ln_g, const float* ln_b, int wid0) {
    int tid = wid0 * 64 + lane_id(); asm volatile("" : "+v"(tid));
    const int lane = tid & 63, wid = tid >> 6;
    const int tok0 = tl * 64, s0 = tok0 % SEQ;
    float scw[3][8];
#pragma unroll
    for (int j = 0; j < 3; ++j)
#pragma unroll
        for (int i = 0; i < 8; ++i) scw[j][i] = sconv_w[j * 256 + (tid & 31) * 8 + i];
    u32x4 sco[4];
#pragma unroll
    for (int k = 0; k < 4; ++k) { const int it = tid + 512 * k;
        const int t = it >> 5, c8 = (it & 31) * 8; const int s = s0 + t; const bf16_t* zr = Z + (size_t)(tok0 + t) * ZLD;
        float xs[8], cgv[8], bg[8], p0[8], p1[8], p2[8];
        ld8(zr + 256 + c8, xs); ld8(zr + 768 + c8, cgv); ld8(zr + 512 + c8, bg);
#pragma unroll
        for (int i = 0; i < 8; ++i) p2[i] = xs[i] * cgv[i];
        if (s >= 1) { ld8(zr - ZLD + 256 + c8, xs); ld8(zr - ZLD + 768 + c8, cgv);
#pragma unroll
            for (int i = 0; i < 8; ++i) p1[i] = xs[i] * cgv[i]; }
        else {
#pragma unroll
            for (int i = 0; i < 8; ++i) p1[i] = 0.f; }
        if (s >= 2) { ld8(zr - 2 * ZLD + 256 + c8, xs); ld8(zr - 2 * ZLD + 768 + c8, cgv);
#pragma unroll
            for (int i = 0; i < 8; ++i) p0[i] = xs[i] * cgv[i]; }
        else {
#pragma unroll
            for (int i = 0; i < 8; ++i) p0[i] = 0.f; }
        float o[8];
#pragma unroll
        for (int i = 0; i < 8; ++i) o[i] = bg[i] * (scw[0][i] * p0[i] + scw[1][i] * p1[i] + scw[2][i] * p2[i]);
        u32x4 w; w.x = cvt_pk_bf16(o[0], o[1]); w.y = cvt_pk_bf16(o[2], o[3]); w.z = cvt_pk_bf16(o[4], o[5]); w.w = cvt_pk_bf16(o[6], o[7]);
        sco[k] = w;
    }
#pragma unroll
    for (int k = 0; k < 4; ++k) { const int it = tid + 512 * k; *(u32x4*)(YC + (size_t)(tok0 + (it >> 5)) * DM + 256 + (it & 31) * 8) = sco[k]; }
    LAS bf16_t* mxb = (LAS bf16_t*)lds;
    LAS bf16_t* wtb = (LAS bf16_t*)(lds + 34816);
    LAS bf16_t* zb = (LAS bf16_t*)(lds + 73728);
    {   u32x4 zr5[5];
#pragma unroll
        for (int k = 0; k < 5; ++k) { const int it = tid + 512 * k; const int i = it >> 5, c8 = (it & 31) * 8; const int s = s0 - 15 + i;
            zr5[k] = (u32x4){0u, 0u, 0u, 0u};
            if (it < 79 * 32 && s >= 0) zr5[k] = *(const u32x4*)(Z + (size_t)(tok0 - 15 + i) * ZLD + c8); }
#pragma unroll
        for (int k = 0; k < 5; ++k) { const int it = tid + 512 * k; if (it < 79 * 32) *(LAS u32x4*)(zb + (it >> 5) * 256 + (it & 31) * 8) = zr5[k]; }
    }
#pragma unroll
    for (int e0 = 0; e0 < 16384; e0 += 512 * 8) {
        float pw[8];
#pragma unroll
        for (int k = 0; k < 8; ++k) pw[k] = pool_w[e0 + 512 * k + tid];
#pragma unroll
        for (int k = 0; k < 8; ++k) { const int e = e0 + 512 * k + tid; const int g = e >> 12, c = (e >> 6) & 63, d = e & 63; wtb[(g * 64 + d) * 72 + c] = (bf16_t)(cvt_pk_bf16(pw[k], 0.f) & 0xffffu); }
    }
    __syncthreads();
    for (int it = tid; it < 64 * 32; it += 512) {
        const int t = it >> 5, c8 = (it & 31) * 8; const int s = s0 + t; const int g = c8 >> 6, w = 2 << g; const int cnt = (s + 1 < w) ? (s + 1) : w;
        float cur[8], sum[8];
        { const u32x4 q = *(const LAS u32x4*)(zb + (15 + t) * 256 + c8);
          cur[0] = bf_lo(q.x); cur[1] = bf_hi(q.x); cur[2] = bf_lo(q.y); cur[3] = bf_hi(q.y); cur[4] = bf_lo(q.z); cur[5] = bf_hi(q.z); cur[6] = bf_lo(q.w); cur[7] = bf_hi(q.w); }
#pragma unroll
        for (int i = 0; i < 8; ++i) sum[i] = cur[i];
        for (int j = 1; j < w; ++j) { const u32x4 q = *(const LAS u32x4*)(zb + (15 + t - j) * 256 + c8);
            sum[0] += bf_lo(q.x); sum[1] += bf_hi(q.x); sum[2] += bf_lo(q.y); sum[3] += bf_hi(q.y); sum[4] += bf_lo(q.z); sum[5] += bf_hi(q.z); sum[6] += bf_lo(q.w); sum[7] += bf_hi(q.w); }
        const float ic = 1.0f / (float)cnt;
        u32x4 o; o.x = cvt_pk_bf16(sum[0] * ic - cur[0], sum[1] * ic - cur[1]); o.y = cvt_pk_bf16(sum[2] * ic - cur[2], sum[3] * ic - cur[3]);
        o.z = cvt_pk_bf16(sum[4] * ic - cur[4], sum[5] * ic - cur[5]); o.w = cvt_pk_bf16(sum[6] * ic - cur[6], sum[7] * ic - cur[7]);
        *(LAS u32x4*)(mxb + t * 264 + c8) = o;
    }
    __syncthreads();
    {
        const int g = wid >> 1, tb = wid & 1, r32 = lane & 31, hi = lane >> 5;
        f32x16 acc0 = {}, acc1 = {};
#pragma unroll
        for (int ks = 0; ks < 4; ++ks) {
            const bf16x8 bm = *(const LAS bf16x8*)(mxb + (tb * 32 + r32) * 264 + g * 64 + ks * 16 + hi * 8);
            const bf16x8 a0 = *(const LAS bf16x8*)(wtb + (g * 64 + r32) * 72 + ks * 16 + hi * 8), a1 = *(const LAS bf16x8*)(wtb + (g * 64 + 32 + r32) * 72 + ks * 16 + hi * 8);
            acc0 = __builtin_amdgcn_mfma_f32_32x32x16_bf16(a0, bm, acc0, 0, 0, 0);
            acc1 = __builtin_amdgcn_mfma_f32_32x32x16_bf16(a1, bm, acc1, 0, 0, 0);
        }
        bf16_t* op = YC + (size_t)(tok0 + tb * 32 + r32) * DM + g * 64;
        f32x4 sav[4], sbv[4];
#pragma unroll
        for (int rg = 0; rg < 4; ++rg) { sav[rg] = *(const f32x4*)(pool_scale + g * 64 + 8 * rg + 4 * hi); sbv[rg] = *(const f32x4*)(pool_scale + g * 64 + 32 + 8 * rg + 4 * hi); }
#pragma unroll
        for (int rg = 0; rg < 4; ++rg) { const int d0 = 8 * rg + 4 * hi;
            const f32x4 sa = sav[rg], sb = sbv[rg];
            u32x2 wa, wb;
            wa.x = cvt_pk_bf16(acc0[4 * rg + 0] * sa.x, acc0[4 * rg + 1] * sa.y); wa.y = cvt_pk_bf16(acc0[4 * rg + 2] * sa.z, acc0[4 * rg + 3] * sa.w);
            wb.x = cvt_pk_bf16(acc1[4 * rg + 0] * sb.x, acc1[4 * rg + 1] * sb.y); wb.y = cvt_pk_bf16(acc1[4 * rg + 2] * sb.z, acc1[4 * rg + 3] * sb.w);
            *(u32x2*)(op + d0) = wa; *(u32x2*)(op + 32 + d0) = wb; }
    }
    __syncthreads();
    LAS bf16_t* ub = (LAS bf16_t*)lds; LAS float* cv = (LAS float*)(lds + 49152);
    {   u32x4 gaw[6], ggw[6];
#pragma unroll
        for (int k = 0; k < 6; ++k) { const int it = tid + 512 * k; const int i = it >> 5, c8 = (it & 31) * 8; const int s = s0 - 30 + i;
            gaw[k] = (u32x4){0u, 0u, 0u, 0u}; ggw[k] = gaw[k];
            if (it < 94 * 32 && s >= 0) { const bf16_t* zr = Z + (size_t)(tok0 - 30 + i) * ZLD; gaw[k] = *(const u32x4*)(zr + 1536 + c8); ggw[k] = *(const u32x4*)(zr + 1792 + c8); } }
#pragma unroll
        for (int k = 0; k < 6; ++k) { const int it = tid + 512 * k;
            float ga[8], gg[8], e[8];
            ga[0] = bf_lo(gaw[k].x); ga[1] = bf_hi(gaw[k].x); ga[2] = bf_lo(gaw[k].y); ga[3] = bf_hi(gaw[k].y); ga[4] = bf_lo(gaw[k].z); ga[5] = bf_hi(gaw[k].z); ga[6] = bf_lo(gaw[k].w); ga[7] = bf_hi(gaw[k].w);
            gg[0] = bf_lo(ggw[k].x); gg[1] = bf_hi(ggw[k].x); gg[2] = bf_lo(ggw[k].y); gg[3] = bf_hi(ggw[k].y); gg[4] = bf_lo(ggw[k].z); gg[5] = bf_hi(ggw[k].z); gg[6] = bf_lo(ggw[k].w); gg[7] = bf_hi(ggw[k].w);
#pragma unroll
            for (int q = 0; q < 8; ++q) e[q] = fast_exp2(-1.4426950408889634f * gg[q]);
#pragma unroll
            for (int q = 0; q < 8; ++q) e[q] = fast_rcp(1.0f + e[q]);
#pragma unroll
            for (int q = 0; q < 8; ++q) e[q] *= ga[q];
            u32x4 w; w.x = cvt_pk_bf16(e[0], e[1]); w.y = cvt_pk_bf16(e[2], e[3]); w.z = cvt_pk_bf16(e[4], e[5]); w.w = cvt_pk_bf16(e[6], e[7]);
            if (it < 94 * 32) *(LAS u32x4*)(ub + (it >> 5) * 256 + (it & 31) * 8) = w; }
    }
    __syncthreads();
    {
        const int ch = tid & 255, half = tid >> 8;
        float wt[31];
#pragma unroll
        for (int j = 0; j < 31; ++j) wt[j] = dw_w[j * 256 + ch];
        const float bias = dw_b[ch];
        float uu[62];
#pragma unroll
        for (int i = 0; i < 62; ++i) uu[i] = bf2f(ub[(half * 32 + i) * 256 + ch]);
#pragma unroll
        for (int t = 0; t < 32; ++t) {
            float a = bias;
#pragma unroll
            for (int j = 0; j < 31; ++j) a += wt[j] * uu[t + j];
            cv[(half * 32 + t) * 256 + ch] = a;
        }
    }
    __syncthreads();
    {
        const f32x4 g4 = ((const f32x4*)ln_g)[lane], b4 = ((const f32x4*)ln_b)[lane];
        f32x4 v[8]; float sm[8];
#pragma unroll
        for (int i = 0; i < 8; ++i) { v[i] = *(const LAS f32x4*)(cv + (wid * 8 + i) * 256 + 4 * lane); sm[i] = (v[i].x + v[i].y) + (v[i].z + v[i].w); }
        wave_sum8(sm);
#pragma unroll
        for (int i = 0; i < 8; ++i) { v[i] = v[i] - sm[i] * (1.0f / 256.0f); sm[i] = (v[i].x * v[i].x + v[i].y * v[i].y) + (v[i].z * v[i].z + v[i].w * v[i].w); }
        wave_sum8(sm);
        u32x2 ow[8];
#pragma unroll
        for (int i = 0; i < 8; ++i) { const float rs = __builtin_amdgcn_rsqf(sm[i] * (1.0f / 256.0f) + EPS);
            const f32x4 y = v[i] * rs * g4 + b4;
            float e0 = fast_exp2(-1.4426950408889634f * y.x), e1 = fast_exp2(-1.4426950408889634f * y.y), e2 = fast_exp2(-1.4426950408889634f * y.z), e3 = fast_exp2(-1.4426950408889634f * y.w);
            e0 = fast_rcp(1.0f + e0); e1 = fast_rcp(1.0f + e1); e2 = fast_rcp(1.0f + e2); e3 = fast_rcp(1.0f + e3);
            ow[i].x = cvt_pk_bf16(y.x * e0, y.y * e1); ow[i].y = cvt_pk_bf16(y.z * e2, y.w * e3); }
#pragma unroll
        for (int i = 0; i < 8; ++i) *(u32x2*)(YC + (size_t)(tok0 + wid * 8 + i) * DM + 768 + 4 * lane) = ow[i];
    }
    __syncthreads();
}

constexpr int DA_KST = 144, DA_VST = 272, DA_KB = 128 * DA_KST, DA_VB = 64 * DA_VST, DA_BUF = DA_KB + DA_VB;
__device__ __forceinline__ float fadd_s(float a, float b) { float r; asm("v_add_f32_e32 %0, %1, %2" : "=v"(r) : "v"(a), "v"(b)); return r; }
template <int NH, bool FIRST>
__device__ __forceinline__ float da_step(const LAS unsigned char* kb, int kroff, int vroff, const bf16x8 (&qr)[2], f32x16& o0, f32x16& o1, f32x16& osum, f32x16& negm, float& mhat) {
    const bf16x8 ones = (bf16x8){0x3F80, 0x3F80, 0x3F80, 0x3F80, 0x3F80, 0x3F80, 0x3F80, 0x3F80};
    float rmax = -INFINITY;
#pragma unroll
    for (int g = 0; g < NH; ++g) {
        const LAS unsigned char* kg = kb + kroff + g * 64 * DA_KST;
        const bf16x8 k0 = *(const LAS bf16x8*)(kg), k1 = *(const LAS bf16x8*)(kg + 32 * DA_KST);
        const bf16x8 k2 = *(const LAS bf16x8*)(kg + 32), k3 = *(const LAS bf16x8*)(kg + 32 * DA_KST + 32);
        f32x16 pa = __builtin_amdgcn_mfma_f32_32x32x16_bf16(k0, qr[0], negm, 0, 0, 0);
        f32x16 pc = __builtin_amdgcn_mfma_f32_32x32x16_bf16(k1, qr[0], negm, 0, 0, 0);
        pa = __builtin_amdgcn_mfma_f32_32x32x16_bf16(k2, qr[1], pa, 0, 0, 0);
        pc = __builtin_amdgcn_mfma_f32_32x32x16_bf16(k3, qr[1], pc, 0, 0, 0);
        bf16x8 vfa[2][2], vfb[2][2];
#pragma unroll
        for (int hh = 0; hh < 2; ++hh)
#pragma unroll
            for (int s = 0; s < 2; ++s) { const LAS unsigned char* vp = kb + DA_KB + vroff + (2 * g + hh) * 64 + s * 32;
                vfa[hh][s] = *(const LAS bf16x8*)(vp); vfb[hh][s] = *(const LAS bf16x8*)(vp + 32 * DA_VST); }
        __builtin_amdgcn_sched_barrier(0);
        if constexpr (FIRST) {
            if (g == 0) {
                float ra = fmaxf(fmaxf(pa[0], pa[1]), pc[0]), rb = fmaxf(fmaxf(pa[2], pa[3]), pc[1]);
                ra = fmaxf(fmaxf(ra, pc[2]), pc[3]);
#pragma unroll
                for (int r = 4; r < 16; r += 4) { ra = fmaxf(fmaxf(ra, pa[r]), pa[r + 1]); rb = fmaxf(fmaxf(rb, pa[r + 2]), pa[r + 3]); ra = fmaxf(fmaxf(ra, pc[r]), pc[r + 1]); rb = fmaxf(fmaxf(rb, pc[r + 2]), pc[r + 3]); }
                rmax = fmaxf(ra, rb);
            }
        }
        if constexpr (FIRST) {
            if (g == 0) {
                const float ra = max32(rmax); mhat = ra; rmax = 0.f;
#pragma unroll
                for (int r = 0; r < 16; ++r) { pa[r] -= ra; pc[r] -= ra; negm[r] = -mhat; }
            }
        }
#pragma unroll
        for (int r = 0; r < 16; r += 2) { pa[r] = fast_exp2(pa[r]); pa[r + 1] = fast_exp2(pa[r + 1]); }
#pragma unroll
        for (int r = 0; r < 16; r += 2) { pc[r] = fast_exp2(pc[r]); pc[r + 1] = fast_exp2(pc[r + 1]); }
        bf16x8 pb[2][2];
#pragma unroll
        for (int hh = 0; hh < 2; ++hh)
#pragma unroll
            for (int s = 0; s < 2; ++s) { const f32x16& q = hh ? pc : pa; u32x4 w;
                w.x = cvtpk_s(q[8 * s + 0], q[8 * s + 1]); w.y = cvtpk_s(q[8 * s + 2], q[8 * s + 3]); w.z = cvtpk_s(q[8 * s + 4], q[8 * s + 5]); w.w = cvtpk_s(q[8 * s + 6], q[8 * s + 7]);
                pb[hh][s] = __builtin_bit_cast(bf16x8, w); }
#pragma unroll
        for (int hh = 0; hh < 2; ++hh)
#pragma unroll
            for (int s = 0; s < 2; ++s) {
                o0 = __builtin_amdgcn_mfma_f32_32x32x16_bf16(vfa[hh][s], pb[hh][s], o0, 0, 0, 0);
                o1 = __builtin_amdgcn_mfma_f32_32x32x16_bf16(vfb[hh][s], pb[hh][s], o1, 0, 0, 0);
                osum = __builtin_amdgcn_mfma_f32_32x32x16_bf16(ones, pb[hh][s], osum, 0, 0, 0);
            }
    }
    return rmax;
}
__device__ __forceinline__ void dattn_unit(LAS unsigned char* lds, const bf16_t* QC, const bf16_t* VT, bf16_t* YC, int b, int h, int u128, float lam, float oscale, const float* subg, int wid0) {
    int tid = wid0 * 64 + lane_id(); asm volatile("" : "+v"(tid));
    const int lane = tid & 63, r32 = lane & 31, hi = lane >> 5; const int wid = __builtin_amdgcn_readfirstlane(tid >> 6);
    const int comp = wid >> 2, wq = wid & 3;
    const size_t tok0 = (size_t)b * SEQ; const int q0 = u128 * 128;
    const bf16_t* KC = QC + (size_t)8 * 8192 * 64;
    const bf16_t* qp = QC + ((size_t)(b * 4 + h) * 8192 + q0 + wq * 32 + r32) * 64 + comp * 32 + hi * 8;
    bf16x8 qr[2]; qr[0] = *(const bf16x8*)qp; qr[1] = *(const bf16x8*)(qp + 16);
    const int NS = u128 + 1;
    const int srow = tid >> 3, sch = tid & 7;
    const bf16_t* ksrc = KC + ((size_t)(b * 4 + h) * 8192 + srow) * 64 + sch * 8;
    const bf16_t* vsrc = VT + (size_t)(h * 64 + srow) * NTOK + tok0 + sch * 8;
    const int kwoff = srow * DA_KST + sch * 16, vwoff = DA_KB + srow * DA_VST + sch * 16;
    const int rsw = (r32 & 0x13) | ((r32 & 4) << 1) | ((r32 & 8) >> 1);
    const int kroff = rsw * DA_KST + comp * 64 + hi * 16;
    const int vroff = r32 * DA_VST + hi * 16;
    f32x16 o0 = {}, o1 = {}, osum = {}; float mhat = 0.f;
    f32x16 negm = {};
    {   const u32x4 k0 = *(const u32x4*)ksrc, k1 = *(const u32x4*)(ksrc + 64 * 64), v0 = *(const u32x4*)vsrc, v1 = *(const u32x4*)(vsrc + 64);
        *(LAS u32x4*)(lds + kwoff) = k0; *(LAS u32x4*)(lds + kwoff + 64 * DA_KST) = k1; *(LAS u32x4*)(lds + vwoff) = v0; *(LAS u32x4*)(lds + vwoff + 128) = v1; }
    __syncthreads();
    for (int s = 0; s < NS; ++s) {
        const bool more = (s + 1 < NS);
        u32x4 k0 = (u32x4){0u, 0u, 0u, 0u}, k1 = k0, v0 = k0, v1 = k0;
        if (more) { const bf16_t* kp = ksrc + (size_t)(s + 1) * 128 * 64; const bf16_t* vp = vsrc + (size_t)(s + 1) * 128;
            k0 = *(const u32x4*)kp; k1 = *(const u32x4*)(kp + 64 * 64); v0 = *(const u32x4*)vp; v1 = *(const u32x4*)(vp + 64); }
        const LAS unsigned char* kb = lds + (s & 1) * DA_BUF;
        if ((s & 1) == 0 && s > 0 && __builtin_expect(__any(osum[0] > 16777216.f), 0)) {
            asm volatile("" ::: "memory");
            const float dl = fmaxf(floorf(__log2f(fmaxf(osum[0], 1.0f))), 0.f); const float alpha = fast_exp2(-dl); mhat += dl;
#pragma unroll
            for (int r = 0; r < 16; ++r) { o0[r] *= alpha; o1[r] *= alpha; osum[r] *= alpha; negm[r] = -mhat; }
        }
        if (s == 0) { if (more || wq >= 2) (void)da_step<2, true>(kb, kroff, vroff, qr, o0, o1, osum, negm, mhat); else (void)da_step<1, true>(kb, kroff, vroff, qr, o0, o1, osum, negm, mhat); }
        else if (more || wq >= 2) (void)da_step<2, false>(kb, kroff, vroff, qr, o0, o1, osum, negm, mhat);
        else (void)da_step<1, false>(kb, kroff, vroff, qr, o0, o1, osum, negm, mhat);
        if (more) { LAS unsigned char* nb = lds + ((s + 1) & 1) * DA_BUF;
            *(LAS u32x4*)(nb + kwoff) = k0; *(LAS u32x4*)(nb + kwoff + 64 * DA_KST) = k1; *(LAS u32x4*)(nb + vwoff) = v0; *(LAS u32x4*)(nb + vwoff + 128) = v1; }
        __syncthreads();
    }
    const float inv = 1.0f / osum[0];
    LAS float* X = (LAS float*)lds;
    if (comp == 1) {
        const float f = inv * lam;
#pragma unroll
        for (int r = 0; r < 16; ++r) { X[((wq * 2 + 0) * 16 + r) * 64 + lane] = o0[r] * f; X[((wq * 2 + 1) * 16 + r) * 64 + lane] = o1[r] * f; }
    }
    __syncthreads();
    if (comp == 0) {
        float ss = 0.f;
#pragma unroll
        for (int r = 0; r < 16; ++r) { o0[r] = o0[r] * inv - X[((wq * 2 + 0) * 16 + r) * 64 + lane]; o1[r] = o1[r] * inv - X[((wq * 2 + 1) * 16 + r) * 64 + lane]; ss += o0[r] * o0[r] + o1[r] * o1[r]; }
        ss = sum32(ss);
        float li_ = oscale; asm volatile("" : "+v"(li_));
        const float rs = (1.0f - li_) / sqrtf(ss * (1.0f / 64.0f) + EPS);
        bf16_t* op = YC + (tok0 + q0 + wq * 32 + r32) * DM + 512 + h * 64;
        f32x4 gav[4], gbv[4];
#pragma unroll
        for (int rg = 0; rg < 4; ++rg) { gav[rg] = *(const f32x4*)(subg + 8 * rg + 4 * hi); gbv[rg] = *(const f32x4*)(subg + 32 + 8 * rg + 4 * hi); }
#pragma unroll
        for (int rg = 0; rg < 4; ++rg) {
            const int d0 = 8 * rg + 4 * hi;
            const f32x4 ga = gav[rg], gb = gbv[rg];
            u32x2 wa, wb;
            wa.x = cvt_pk_bf16(o0[4 * rg + 0] * rs * ga.x, o0[4 * rg + 1] * rs * ga.y); wa.y = cvt_pk_bf16(o0[4 * rg + 2] * rs * ga.z, o0[4 * rg + 3] * rs * ga.w);
            wb.x = cvt_pk_bf16(o1[4 * rg + 0] * rs * gb.x, o1[4 * rg + 1] * rs * gb.y); wb.y = cvt_pk_bf16(o1[4 * rg + 2] * rs * gb.z, o1[4 * rg + 3] * rs * gb.w);
            *(u32x2*)(op + d0) = wa; *(u32x2*)(op + 32 + d0) = wb;
        }
    }
    __syncthreads();
}


#define XB_TMO      128
#define XB_XCNT(j)  (256  + 64 * (j))
#define XB_XSUB(j)  (1280 + 64 * (j))
#define XB_XGEN(j)  (2304 + 64 * (j))
#define XB_TOP      3328
#define XB_TOPGEN   3392
#define XCD_BAR_WORDS 3456
#define XB_SPIN_CAP (1u << 18)
__device__ __forceinline__ unsigned xb_ld(unsigned* p)              { return __hip_atomic_load(p, __ATOMIC_RELAXED, __HIP_MEMORY_SCOPE_AGENT); }
__device__ __forceinline__ unsigned xb_add(unsigned* p, unsigned v) { return __hip_atomic_fetch_add(p, v, __ATOMIC_RELAXED, __HIP_MEMORY_SCOPE_AGENT); }
__device__ __forceinline__ unsigned xb_xcc_id() { return (unsigned)__builtin_amdgcn_s_getreg((3 << 11) | 20) & 0xFu; }
#define XB_SPIN(cond, bar) do { unsigned _sp = 0; while (cond) { __builtin_amdgcn_s_sleep(1); \
    if ((++_sp & 255u) == 0u) { if (xb_ld(&(bar)[XB_TMO])) break; if (_sp > XB_SPIN_CAP) { atomicAdd(&(bar)[XB_TMO], 1u); break; } } } } while (0)
struct XcdBarrier { unsigned* bar; unsigned x; volatile LAS unsigned* st; };
__device__ __forceinline__ XcdBarrier xcd_barrier_post(unsigned* bar, volatile LAS unsigned* st) {
    XcdBarrier b; b.bar = bar; b.x = xb_xcc_id(); b.st = st;
    if (threadIdx.x == 0) (void)xb_add(&bar[XB_XCNT(b.x)], 1u);
    return b;
}
__device__ __forceinline__ void xcd_barrier_complete(unsigned* bar, unsigned x, unsigned& nloc, unsigned& nx) {
    const unsigned G = gridDim.x * gridDim.y * gridDim.z;
    unsigned sum, cnt, mine, sp = 0u;
    for (;;) {
        sum = 0u; cnt = 0u; mine = 0u;
#pragma unroll
        for (unsigned j = 0; j < 16; ++j) { const unsigned c = xb_ld(&bar[XB_XCNT(j)]); sum += c; cnt += (c > 0u) ? 1u : 0u; mine = (j == x) ? c : mine; }
        if (sum == G) break;
        __builtin_amdgcn_s_sleep(1);
        if ((++sp & 255u) == 0u) { if (xb_ld(&bar[XB_TMO])) break; if (sp > XB_SPIN_CAP) { atomicAdd(&bar[XB_TMO], 1u); break; } }
    }
    nloc = mine > 0u ? mine : 1u; nx = cnt > 0u ? cnt : 1u;
}
__device__ __forceinline__ void xcd_barrier(const XcdBarrier& b, int wid0) {
    asm volatile("s_waitcnt vmcnt(0)" ::: "memory");
    __syncthreads();
    if (wid0 == 0 && lane_id() == 0) {
        unsigned* bar = b.bar;
        __builtin_amdgcn_s_waitcnt(0);
        unsigned nloc = b.st[0], nx = b.st[1];
        if (nloc == 0u) { xcd_barrier_complete(bar, b.x, nloc, nx); b.st[0] = nloc; b.st[1] = nx; }
        const unsigned old = xb_add(&bar[XB_XSUB(b.x)], 1u);
        const unsigned gen = old / nloc;
        if (old + 1u == (gen + 1u) * nloc) {
            __builtin_amdgcn_fence(__ATOMIC_RELEASE, "agent");
            asm volatile("s_waitcnt vmcnt(0)" ::: "memory");
            const unsigned og = xb_add(&bar[XB_TOP], 1u);
            const unsigned tg = og / nx;
            if (og + 1u == (tg + 1u) * nx) xb_add(&bar[XB_TOPGEN], 1u);
            else XB_SPIN(xb_ld(&bar[XB_TOPGEN]) == tg, bar);
            __builtin_amdgcn_fence(__ATOMIC_ACQUIRE, "agent");
            xb_add(&bar[XB_XGEN(b.x)], 1u);
            asm volatile("s_waitcnt vmcnt(0)" ::: "memory");
        } else {
            XB_SPIN(xb_ld(&bar[XB_XGEN(b.x)]) == gen, bar);
            __builtin_amdgcn_fence(__ATOMIC_ACQUIRE, "agent");
            asm volatile("s_waitcnt vmcnt(0)" ::: "memory");
        }
    }
    __syncthreads();
}

#define IN(k) ld_ptr(ptab, (k))
__device__ __forceinline__ TItem decode_item(int slot, int idx, int total, volatile LAS unsigned long long* ptab, bf16_t* Wb) {
    TItem t; t.valid = idx < total; t.W = nullptr; t.WT = nullptr; t.gk = nullptr; t.K = 0; t.N = 0; t.drow0 = 0; t.k0 = 0; t.n0 = 0;
    if (!t.valid) return t;
    int l, r;
    if (slot == 0) { if (idx < 2112) { l = 0; r = idx; } else if (idx < 3968) { l = 0; r = idx + 2112; } else { l = 1; r = idx - 3968 + 5312; } }
    else if (slot == 1) { l = 0; r = idx + 2112; }
    else if (slot == 2) { l = 1; r = (idx < 2112) ? idx : idx + 2112; }
    else if (slot == 3) { l = 1; r = idx + 5824; }
    else { l = 1; r = idx + 2112; }
    bf16_t* Wl = Wb + (size_t)l * LW;
    const float* src; int K, N; bf16_t* dst; int kind; int gi = -1;
    if (r < 704) { src = IN(4) + (size_t)l * DM * FF; K = DM; N = FF; dst = Wl + OW_GU1; kind = 1; gi = 3; }
    else if (r < 1408) { r -= 704; src = IN(5) + (size_t)l * DM * FF; K = DM; N = FF; dst = Wl + OW_GU1; kind = 2; gi = 3; }
    else if (r < 2112) { r -= 1408; src = IN(6) + (size_t)l * DM * FF; K = FF; N = DM; dst = Wl + OW_D1; kind = 0; }
    else if (r < 2816) { r -= 2112; src = IN(32) + (size_t)l * DM * FF; K = DM; N = FF; dst = Wl + OW_GU2; kind = 1; gi = 31; }
    else if (r < 3520) { r -= 2816; src = IN(33) + (size_t)l * DM * FF; K = DM; N = FF; dst = Wl + OW_GU2; kind = 2; gi = 31; }
    else if (r < 4224) { r -= 3520; src = IN(34) + (size_t)l * DM * FF; K = FF; N = DM; dst = Wl + OW_D2; kind = 0; }
    else if (r < 4800) { r -= 4224; src = IN(9) + (size_t)l * DM * 2304; K = DM; N = 2304; dst = Wl + OW_IN; kind = 3; gi = 8; }
    else if (r < 5056) { r -= 4800; src = IN(22) + (size_t)l * DM * DM; K = DM; N = DM; dst = Wl + OW_O; kind = 0; }
    else if (r < 5312) { r -= 5056; src = IN(26) + (size_t)l * DM * DM; K = DM; N = DM; dst = Wl + OW_Q; kind = 0; gi = 24; }
    else if (r < 5568) { r -= 5312; src = IN(27) + (size_t)l * DM * DM; K = DM; N = DM; dst = Wl + OW_K; kind = 0; }
    else if (r < 5824) { r -= 5568; src = IN(28) + (size_t)l * DM * DM; K = DM; N = DM; dst = Wl + OW_V; kind = 0; }
    else { r -= 5824; src = IN(29) + (size_t)l * DM * DM; K = DM; N = DM; dst = Wl + OW_XO; kind = 0; }
    const int nblk = N / 64, kb = r / nblk, nb = r % nblk, n0 = 64 * nb;
    int drow0 = n0;
    if (kind == 1) drow0 = (n0 >> 7) * 256 + (n0 & 127);
    else if (kind == 2) drow0 = (n0 >> 7) * 256 + 128 + (n0 & 127);
    else if (kind == 3) { if (n0 >= 1792) drow0 = n0 - 256; else if (n0 >= 1536) drow0 = n0 + 512; }
    if (gi >= 0) t.gk = IN(gi) + l * DM;
    t.W = src; t.WT = dst; t.K = K; t.N = N; t.drow0 = drow0; t.k0 = 64 * kb; t.n0 = n0;
    return t;
}
__device__ __forceinline__ void convert_slot(int slot, int part, int nparts, volatile LAS unsigned long long* ptab, bf16_t* Wb, LAS unsigned char* lds, int wid) {
    const int total = (slot == 0) ? 4480 : (slot == 1) ? 2112 : (slot == 2) ? 3200 : (slot == 3) ? 256 : 2112;
    LAS float* scr = (LAS float*)(lds + wid * 16640);
    int lane = lane_id(); asm volatile("" : "+v"(lane));
    for (int idx0 = part; idx0 < total; idx0 += 2 * nparts) {
        TItem ta, tb; f32x4 va[16], vb[16];
        ta = decode_item(slot, idx0, total, ptab, Wb); tb = decode_item(slot, idx0 + nparts, total, ptab, Wb);
        ti_load(ta, va, lane); ti_load(tb, vb, lane);
        ti_finish(ta, va, scr, lane); ti_finish(tb, vb, scr, lane);
    }
}
#undef IN

__global__ void __launch_bounds__(512, 2) mega_fwd(Params p) {
    extern __shared__ __attribute__((aligned(16))) unsigned char lds_raw[];
    LAS unsigned char* lds = (LAS unsigned char*)lds_raw;
    cg::grid_group grid = cg::this_grid();
    const int wid = __builtin_amdgcn_readfirstlane((int)(threadIdx.x >> 6));
    const int tid = wid * 64 + lane_id();
    const int G = gridDim.x, bx = blockIdx.x;
    const int gw = bx * 8 + wid, NGW = G * 8;
    unsigned char* ws = p.ws;
    bf16_t* Wb = (bf16_t*)(ws + WS_W);
    bf16_t* XN = (bf16_t*)(ws + WS_XN);
    bf16_t* BIG = (bf16_t*)(ws + WS_BIG);
    bf16_t* Yb = (bf16_t*)(ws + WS_Y);
    bf16_t* KV = (bf16_t*)(ws + WS_KV);
    float* RSTD = (float*)(ws + WS_CTL + 131072 + 524288);
    float* SLOTS = (float*)(ws + WS_CTL + 131072);
    unsigned* PCNT = (unsigned*)(ws + WS_CTL + 16384);
    unsigned xk = 0;
#define GSYNC() xcd_barrier(bar, wid)
#define LSYNC() do { asm volatile("s_waitcnt vmcnt(0)" ::: "memory"); __builtin_amdgcn_fence(__ATOMIC_RELEASE, "workgroup"); __syncthreads(); __builtin_amdgcn_fence(__ATOMIC_ACQUIRE, "workgroup"); } while (0)
    volatile LAS unsigned long long* ptab = (volatile LAS unsigned long long*)(lds + 146432 + 128);
    volatile LAS unsigned* bst = (volatile LAS unsigned*)(lds + 146432);
    if (tid == 0) { bst[0] = 0u; bst[1] = 0u; }
    __syncthreads();
    XcdBarrier bar = xcd_barrier_post((unsigned*)(ws + WS_CTL), bst);
    if (tid == 0) {
#pragma unroll
        for (int i = 0; i < 36; ++i) ptab[i] = (unsigned long long)p.in[i];
    }
    __syncthreads();
#define IN(k) ld_ptr(ptab, (k))

    {
        convert_slot(0, gw, NGW, ptab, Wb, lds, wid);
        rowpass0(IN(0), XN, RSTD, gw, NGW, lane_id());
        rowpass<false, true>(IN(1), nullptr, nullptr, nullptr, 0.f, Yb, IN(25), 512, gw, NGW, lane_id());
        rowpass<false, true>(IN(1), nullptr, nullptr, nullptr, 0.f, Yb + 512 * DM, IN(25) + DM, 512, gw, NGW, lane_id());
    }
    grid.sync();
#pragma unroll 1
    for (int i = 0; i < 4; ++i) {
        const int l = i >> 1, isv = i & 1;
        const bf16_t* MN = Yb + (size_t)l * 512 * DM; const bf16_t* Wl = Wb + (size_t)l * LW;
        pg8::Gemm g = isv ? pg8::make_gemm(Wl + OW_V, MN, DM, 512, DM, DM, DM) : pg8::make_gemm(MN, Wl + OW_K, 512, DM, DM, DM, DM);
        pg8::StaticOrder S; S.init(g.M, g.N, G, (bx + 2 * G - 128 - 8 * i) % G);
        pg8::EpiOut E{KV + (size_t)l * 1048576 + (isv ? 524288 : 0), isv ? 512 : DM, 1.0f, nullptr, nullptr};
        pg8::gemm_phase<pg8::EpiOut, pg8::StaticOrder, true, true>(lds, g, S, E, wid);
    }

#pragma unroll 1
    for (int l = 0; l < 2; ++l) {
        const bf16_t* Wl = Wb + (size_t)l * LW;
        const bf16_t* KX = KV + (size_t)l * 1048576; const bf16_t* VXT = KX + 524288;
#pragma unroll 1
        for (int ff = 0; ff < 2; ++ff) {
            if (ff == 1) {
                {
                    pg8::Gemm g = pg8::make_gemm(XN, Wl + OW_IN, NTOK, ZLD, DM, DM, DM);
                    pg8::StaticOrder S; S.init(NTOK, ZLD, G, bx);
                    pg8::EpiWin E{BIG, ZLD, (const int*)IN(2), 0.25503486f, RSTD, BIG + (size_t)NTOK * ZLD + (size_t)256 * NTOK};
                    pg8::gemm_phase<pg8::EpiWin, pg8::StaticOrder, true, true>(lds, g, S, E, wid);
                }
                {
                    pg8::Gemm g = pg8::make_gemm(Wl + OW_IN + (size_t)2048 * DM, XN, 256, NTOK, DM, DM, DM);
                    pg8::StaticOrder S; S.init(256, NTOK, G, bx);
                    pg8::EpiOutCS E{BIG + (size_t)NTOK * ZLD, NTOK, 1.0f, nullptr, RSTD};
                    pg8::gemm_phase<pg8::EpiOutCS, pg8::StaticOrder, true, true>(lds, g, S, E, wid);
                    if (l == 0 && bx >= 64) convert_slot(2, (bx - 64) * 8 + wid, 192 * 8, ptab, Wb, lds, wid);
                }
                GSYNC();
                {
                    bf16_t* YC = Yb; const bf16_t* Z = BIG; const bf16_t* VT = BIG + (size_t)NTOK * ZLD;
#ifdef PROBE_LM2
                    for (int rep = 0; rep < 2; ++rep)
#endif
                    for (int tl = bx; tl < 256; tl += G)
                        light_mixers_tile(lds, Z, YC, tl, IN(10) + (size_t)l * 16384, IN(11) + l * 256, IN(12) + l * 768, IN(18) + l * 31 * 256, IN(19) + l * 256, IN(20) + l * 256, IN(21) + l * 256, wid);
                    float d1 = 0.f, d2 = 0.f;
                    int lane_l = lane_id(); asm volatile("" : "+v"(lane_l));
                    if (lane_l < 32) { d1 = IN(13)[l * 32 + lane_l] * IN(14)[l * 32 + lane_l]; d2 = IN(15)[l * 32 + lane_l] * IN(16)[l * 32 + lane_l]; }
                    d1 = wave_sum(d1); d2 = wave_sum(d2);
                    const float lam_init = __uint_as_float((unsigned)__builtin_amdgcn_readfirstlane((l == 0) ? (int)0x3e4ccccd : (int)0x3eb60549));
                    const float lam = __uint_as_float((unsigned)__builtin_amdgcn_readfirstlane((int)__float_as_uint(expf(d1) - expf(d2) + lam_init)));
                    const float osc = __uint_as_float((unsigned)__builtin_amdgcn_readfirstlane((int)__float_as_uint(1.0f - lam_init)));
#ifdef PROBE_ATT2
                    for (int rep = 0; rep < 2; ++rep)
#endif
                    for (int pr = bx; pr < 256; pr += G) {
                        const int bh = pr & 7, s = pr >> 3;
                        dattn_unit(lds, VT + (size_t)256 * NTOK, VT, YC, bh >> 2, bh & 3, s, lam, lam_init, IN(17) + l * 64, wid);
                        dattn_unit(lds, VT + (size_t)256 * NTOK, VT, YC, bh >> 2, bh & 3, 63 - s, lam, lam_init, IN(17) + l * 64, wid);
                    }
                }
                GSYNC();
                {
                    pg8::Gemm g = pg8::make_gemm(Yb, Wl + OW_O, NTOK, DM, DM, DM, DM);
                    pg8::StaticOrder S; S.init(NTOK, DM, G, bx);
                    pg8::EpiRes<false> E{XN, IN(23) + l * DM, 1.0f, RSTD, nullptr, SLOTS, PCNT, xk};
                    pg8::gemm_phase<pg8::EpiRes<false>, pg8::StaticOrder, false, true>(lds, g, S, E, wid);
                    xk += 1;
                }
                GSYNC();
                {
                    pg8::Gemm g = pg8::make_gemm(XN, Wl + OW_Q, NTOK, DM, DM, DM, DM);
                    pg8::StaticOrder S; S.init(NTOK, DM, G, bx);
                    pg8::EpiOut E{BIG, DM, 0.09016844005556021f, RSTD, nullptr};
                    pg8::gemm_phase<pg8::EpiOut, pg8::StaticOrder, true, true>(lds, g, S, E, wid);
                }
                LSYNC();
                {
                    pg8::Gemm g = pg8::make_gemm(BIG, KX, NTOK, DM, 256, DM, DM);
                    g.a_pn = 256; g.b_pn = 256; g.b_pb = (long)256 * DM; g.bshift = 5;
                    pg8::StaticOrder S; S.init(NTOK, DM, G, bx);
                    pg8::EpiSoftmax E{BIG + (size_t)NTOK * DM, DM};
                    pg8::gemm_phase<pg8::EpiSoftmax, pg8::StaticOrder, false, true>(lds, g, S, E, wid);
                }
                LSYNC();
                {
                    pg8::Gemm g = pg8::make_gemm(BIG + (size_t)NTOK * DM, VXT, NTOK, DM, 256, DM, 512);
                    g.a_pn = 256; g.b_pn = (long)256 * 512; g.b_pb = 256; g.bshift = 5;
                    pg8::StaticOrder S; S.init(NTOK, DM, G, bx);
                    pg8::EpiOut E{BIG, DM, 1.0f, nullptr, nullptr};
                    pg8::gemm_phase<pg8::EpiOut, pg8::StaticOrder, true, true>(lds, g, S, E, wid);
                }
                GSYNC();
                {
                    pg8::Gemm g = pg8::make_gemm(BIG, Wl + OW_XO, NTOK, DM, DM, DM, DM);
                    pg8::StaticOrder S; S.init(NTOK, DM, G, bx);
                    pg8::EpiRes<false> E{XN, IN(30) + l * DM, 1.0f, RSTD, nullptr, SLOTS, PCNT, xk};
                    pg8::gemm_phase<pg8::EpiRes<false>, pg8::StaticOrder, false, true>(lds, g, S, E, wid);
                    xk += 1;
                }
                GSYNC();
            }
            {
                pg8::Gemm g = pg8::make_gemm(XN, Wl + (ff ? OW_GU2 : OW_GU1), NTOK, 2 * FF, DM, DM, DM);
                pg8::StaticOrder S; S.init(NTOK, 2 * FF, G, bx);
                pg8::EpiSwiGLU E{BIG, FF, RSTD};
                pg8::gemm_phase<pg8::EpiSwiGLU, pg8::StaticOrder, true, true>(lds, g, S, E, wid);
                if (bx >= 128 && !(l == 1 && ff == 1)) {
                    const int slot = (l == 0) ? (ff == 0 ? 1 : 3) : 4;
                    convert_slot(slot, (bx - 128) * 8 + wid, 128 * 8, ptab, Wb, lds, wid);
                }
            }
            GSYNC();
            {
                pg8::Gemm g = pg8::make_gemm(BIG, Wl + (ff ? OW_D2 : OW_D1), NTOK, DM, FF, FF, FF);
                pg8::StaticOrder S; S.init(NTOK, DM, G, bx);
                if (ff == 1 && l == 1) {
                    pg8::EpiRes<true> E{XN, IN(35) + l * DM, 0.5f, RSTD, p.out, SLOTS, PCNT, xk};
                    pg8::gemm_phase<pg8::EpiRes<true>, pg8::StaticOrder, false, true>(lds, g, S, E, wid);
                } else {
                    pg8::EpiRes<false> E{XN, IN(ff ? 35 : 7) + l * DM, 0.5f, RSTD, nullptr, SLOTS, PCNT, xk};
                    pg8::gemm_phase<pg8::EpiRes<false>, pg8::StaticOrder, false, true>(lds, g, S, E, wid);
                    xk += 1;
                }
            }
            if (!(ff == 1 && l == 1)) GSYNC();
        }
    }
}

extern "C" void kernel_launch(void* const* d_in, const int* in_sizes, int n_in, void* d_out, int out_size, void* d_ws, size_t ws_size, hipStream_t stream) {
    static int grid = 0;
    if (grid == 0) {
        if (n_in != 36 || out_size != NTOK * DM || ws_size < WS_END) { fprintf(stderr, "kernel_launch: unexpected problem (n_in %d out %d ws %zu)\n", n_in, out_size, ws_size); grid = -1; return; }
        int dev = 0, cus = 0, per_cu = 0;
        hipGetDevice(&dev);
        hipDeviceGetAttribute(&cus, hipDeviceAttributeMultiprocessorCount, dev);
        if (hipFuncSetAttribute((const void*)mega_fwd, hipFuncAttributeMaxDynamicSharedMemorySize, LDS_BYTES) != hipSuccess) { fprintf(stderr, "kernel_launch: hipFuncSetAttribute failed\n"); grid = -1; return; }
        hipOccupancyMaxActiveBlocksPerMultiprocessor(&per_cu, (const void*)mega_fwd, 512, LDS_BYTES);
        if (per_cu < 1) { fprintf(stderr, "kernel_launch: occupancy query says %d\n", per_cu); per_cu = 1; }
        (void)hipGetLastError();
        grid = cus;
        if (grid != 256) { fprintf(stderr, "kernel_launch: %d CUs (this kernel needs 256)\n", grid); grid = -1; return; }
    }
    if (grid < 0) return;
    if (hipMemsetAsync((char*)d_ws + WS_CTL, 0, 65536, stream) != hipSuccess) { fprintf(stderr, "kernel_launch: memset failed\n"); return; }
    Params p{};
    for (int i = 0; i < 36; ++i) p.in[i] = (const float*)d_in[i];
    p.out = (float*)d_out; p.ws = (unsigned char*)d_ws;
    void* args[] = {&p};
    hipError_t e = hipLaunchCooperativeKernel((const void*)mega_fwd, dim3(grid), dim3(512), args, LDS_BYTES, stream);
    if (e != hipSuccess) fprintf(stderr, "cooperative launch failed: %s (grid %d)\n", hipGetErrorString(e), grid);
}
```

```cpp
#include <hip/hip_runtime.h>
#include <hip/hip_cooperative_groups.h>
#include <cstdio>
#include <cstdint>
#include <cmath>
namespace cg = cooperative_groups;

#define LAS __attribute__((address_space(3)))
typedef unsigned short bf16_t;
typedef short bf16x8 __attribute__((ext_vector_type(8)));
typedef float f32x4 __attribute__((ext_vector_type(4)));
typedef float f32x16 __attribute__((ext_vector_type(16)));
typedef unsigned u32x4 __attribute__((ext_vector_type(4)));
typedef unsigned u32x2 __attribute__((ext_vector_type(2)));

#ifndef USE_CG_SYNC
#define USE_CG_SYNC 1
#endif

constexpr int NTOK = 16384, DM = 1024, FF = 2816, SEQ = 8192, ZLD = 2048;
constexpr float EPS = 1e-6f;
constexpr size_t LW = 24903680;
constexpr size_t OW_GU1 = 0, OW_D1 = 5767168, OW_GU2 = 8650752, OW_D2 = 14417920, OW_IN = 17301504, OW_O = 19660800,
                 OW_Q = 20709376, OW_K = 21757952, OW_V = 22806528, OW_XO = 23855104;
constexpr size_t WS_W = 0, WS_XN = 99614720, WS_BIG = 133169152, WS_Y = 225443840, WS_KV = 258998272, WS_CTL = 263192576, WS_END = 263192576 + 131072 + 524288 + 262144;
constexpr int LDS_BYTES = 147456;
constexpr int ITEMS_PER_LAYER = 6080;

struct Params {
    const float* in[36];
    float* out;
    unsigned char* ws;
};

__device__ __forceinline__ unsigned cvt_pk_bf16(float lo, float hi) { unsigned r; asm volatile("v_cvt_pk_bf16_f32 %0, %1, %2" : "=v"(r) : "v"(lo), "v"(hi)); return r; }
typedef float f32x2_t __attribute__((ext_vector_type(2))); typedef __bf16 bf16x2_t __attribute__((ext_vector_type(2)));
__device__ __forceinline__ unsigned cvtpk_s(float lo, float hi) { f32x2_t v = {lo, hi}; bf16x2_t b = __builtin_convertvector(v, bf16x2_t); return __builtin_bit_cast(unsigned, b); }
__device__ __forceinline__ int lane_id() { int l; asm volatile("v_mbcnt_lo_u32_b32 %0, -1, 0\n\tv_mbcnt_hi_u32_b32 %0, -1, %0" : "=v"(l)); return l; }
__device__ __forceinline__ float bf_lo(unsigned w) { return __uint_as_float(w << 16); }
__device__ __forceinline__ float bf_hi(unsigned w) { return __uint_as_float(w & 0xffff0000u); }
__device__ __forceinline__ float bf2f(bf16_t h) { return __uint_as_float(((unsigned)h) << 16); }
template <int M> __device__ __forceinline__ float shx(float v) {
    static_assert(M < 32, "use sum32 / max32 for the half-wave exchange");
    return __uint_as_float((unsigned)__builtin_amdgcn_ds_swizzle((int)__float_as_uint(v), (M << 10) | 0x1f));
}
__device__ __forceinline__ float sum32(float v) { auto rr = __builtin_amdgcn_permlane32_swap(__float_as_uint(v), __float_as_uint(v), false, false); return __uint_as_float(rr[0]) + __uint_as_float(rr[1]); }
__device__ __forceinline__ float max32(float v) { auto rr = __builtin_amdgcn_permlane32_swap(__float_as_uint(v), __float_as_uint(v), false, false); return fmaxf(__uint_as_float(rr[0]), __uint_as_float(rr[1])); }
__device__ __forceinline__ float wave_sum(float v) {
    v += shx<1>(v); v += shx<2>(v); v += shx<4>(v); v += shx<8>(v); v += shx<16>(v);
    { auto rr = __builtin_amdgcn_permlane32_swap(__float_as_uint(v), __float_as_uint(v), false, false); v = __uint_as_float(rr[0]) + __uint_as_float(rr[1]); }
    return v;
}
__device__ __forceinline__ float fast_exp2(float x) { return __builtin_amdgcn_exp2f(x); }
__device__ __forceinline__ float fast_rcp(float x) { return __builtin_amdgcn_rcpf(x); }
__device__ __forceinline__ float sigmoidf_(float x) { return fast_rcp(1.0f + fast_exp2(-1.4426950408889634f * x)); }
__device__ __forceinline__ void ld8(const bf16_t* p, float (&f)[8]) {
    const u32x4 w = *(const u32x4*)p;
    f[0] = bf_lo(w.x); f[1] = bf_hi(w.x); f[2] = bf_lo(w.y); f[3] = bf_hi(w.y); f[4] = bf_lo(w.z); f[5] = bf_hi(w.z); f[6] = bf_lo(w.w); f[7] = bf_hi(w.w);
}

__device__ __forceinline__ const float* ld_ptr(volatile LAS unsigned long long* tab, int k) {
    const unsigned long long v = tab[k];
    const unsigned lo = __builtin_amdgcn_readfirstlane((unsigned)v), hi = __builtin_amdgcn_readfirstlane((unsigned)(v >> 32));
    return (const float*)(((unsigned long long)hi << 32) | lo);
}

namespace pg8 {
constexpr int BM = 256, BK = 64, HALF = 128, HTB = HALF * BK * 2, STAGE_BYTES = 8 * HTB, NXCD = 8, WGM = 8;
__host__ __device__ __forceinline__ int lds_byte(int r, int c) { const int st = (r >> 4) * 2 + (c >> 5), rr = r & 15, cc = c & 31, ob = rr * 64 + cc * 2; return st * 1024 + (ob ^ (((ob >> 9) & 1) << 5)); }
__host__ __device__ __forceinline__ void stage_rc(int b, int& R, int& C) { const int st = b / 1024, sb = b % 1024, swz = sb ^ (((sb >> 9) & 1) << 5); R = (st >> 1) * 16 + swz / 64; C = (st & 1) * 32 + (swz % 64) / 2; }
__host__ __device__ __forceinline__ int perm32(int rho) { const int n = rho >> 4, i = rho & 15; return 8 * (i >> 2) + 4 * n + (i & 3); }

struct Unit { int pm, pn; };
struct Gemm { const bf16_t* A; const bf16_t* Bt; int M, N, K, lda, ldb; long a_pm, a_pn, b_pn, b_pb; int bshift; };
__device__ __forceinline__ Gemm make_gemm(const bf16_t* A, const bf16_t* Bt, int M, int N, int K, int lda, int ldb) {
    Gemm g; g.A = A; g.Bt = Bt; g.M = M; g.N = N; g.K = K; g.lda = lda; g.ldb = ldb; g.a_pm = (long)BM * lda; g.a_pn = 0; g.b_pn = (long)BM * ldb; g.b_pb = 0; g.bshift = 0; return g;
}

struct StaticOrder {
    int nM, nN, nwg, G, c;
    __device__ void init(int M, int N, int G_, int c_) { nM = M / BM; nN = N / BM; nwg = nM * nN; G = G_; c = c_; }
    __device__ bool next(int i, Unit& u) const {
        const long L = (long)i * G + c; if (L >= nwg) return false;
        int wgid = (int)L; { const int q = nwg / NXCD, r = nwg % NXCD, xcd = wgid % NXCD, off = wgid / NXCD; wgid = (xcd < r ? xcd * (q + 1) : r * (q + 1) + (xcd - r) * q) + off; }
        const int nig = WGM * nN, gid = wgid / nig, fm = gid * WGM, gsz = (nM - fm) < WGM ? (nM - fm) : WGM;
        u.pm = fm + ((wgid % nig) % gsz); u.pn = (wgid % nig) / gsz; return true;
    }
};

__device__ __forceinline__ float rstd_of(const float* pss, int row) { const f32x4 p = *(const f32x4*)(pss + 4 * (size_t)row); return __builtin_amdgcn_rsqf(((p.x + p.y) + (p.z + p.w)) * (1.0f / 1024.0f) + EPS); }
__device__ __forceinline__ float pss_lane(const float* pss, int row, int fq) { return pss[4 * (size_t)row + fq]; }
__device__ __forceinline__ float rstd_fin(float v) { v += shx<16>(v); v = sum32(v); return __builtin_amdgcn_rsqf(v * (1.0f / 1024.0f) + EPS); }
template <int K> __device__ __forceinline__ float bcast16(float v) {
    return __uint_as_float((unsigned)__builtin_amdgcn_ds_swizzle((int)__float_as_uint(v), 0x10 | (K << 5)));
}
template <bool HAS_CS> struct EpiOutT {
    static constexpr bool PERM = true, AFTER_DRAIN = false;
    bf16_t* O; int ldc; float sc; const float* rs; const float* cs;
    __device__ __forceinline__ void operator()(const f32x4 (&acc)[2][2][4][2], const Unit& u, int wr, int wc, int fr, int fq) const {
        const int row0 = u.pm * BM + wr * 64 + fr; const int col0 = u.pn * BM + wc * 32 + 8 * fq;
        f32x4 cv[2][2];
        if constexpr (HAS_CS) {
            const float r = rstd_of(cs, col0 + (fr >> 3) * HALF + (fr & 7));
            cv[0][0] = (f32x4){bcast16<0>(r), bcast16<1>(r), bcast16<2>(r), bcast16<3>(r)};   cv[0][1] = (f32x4){bcast16<4>(r), bcast16<5>(r), bcast16<6>(r), bcast16<7>(r)};
            cv[1][0] = (f32x4){bcast16<8>(r), bcast16<9>(r), bcast16<10>(r), bcast16<11>(r)}; cv[1][1] = (f32x4){bcast16<12>(r), bcast16<13>(r), bcast16<14>(r), bcast16<15>(r)};
        } else {
#pragma unroll
            for (int bj = 0; bj < 2; ++bj)
#pragma unroll
                for (int n = 0; n < 2; ++n) cv[bj][n] = (f32x4){1.f, 1.f, 1.f, 1.f};
        }
        float rsv[2][4];
#pragma unroll
        for (int ai = 0; ai < 2; ++ai)
#pragma unroll
            for (int m = 0; m < 4; ++m) rsv[ai][m] = rs ? pss_lane(rs, row0 + ai * HALF + m * 16, fq) : 0.f;
        if (rs) {
#pragma unroll
            for (int ai = 0; ai < 2; ++ai)
#pragma unroll
                for (int m = 0; m < 4; ++m) rsv[ai][m] = rstd_fin(rsv[ai][m]);
        } else {
#pragma unroll
            for (int ai = 0; ai < 2; ++ai)
#pragma unroll
                for (int m = 0; m < 4; ++m) rsv[ai][m] = 1.0f;
        }
#pragma unroll
        for (int ai = 0; ai < 2; ++ai)
#pragma unroll
            for (int m = 0; m < 4; ++m) { bf16_t* rowp = O + (size_t)(row0 + ai * HALF + m * 16) * ldc + col0;
                const float rsc = rsv[ai][m];
#pragma unroll
                for (int bj = 0; bj < 2; ++bj) { f32x4 v0, v1;
                    if constexpr (HAS_CS) { v0 = acc[ai][bj][m][0] * cv[bj][0] * rsc; v1 = acc[ai][bj][m][1] * cv[bj][1] * rsc; }
                    else { const float s_ = sc * rsc; v0 = acc[ai][bj][m][0] * s_; v1 = acc[ai][bj][m][1] * s_; }
                    u32x4 w; w.x = cvt_pk_bf16(v0[0], v0[1]); w.y = cvt_pk_bf16(v0[2], v0[3]); w.z = cvt_pk_bf16(v1[0], v1[1]); w.w = cvt_pk_bf16(v1[2], v1[3]);
                    *(u32x4*)(rowp + bj * HALF) = w; } }
    }
};
typedef EpiOutT<false> EpiOut; typedef EpiOutT<true> EpiOutCS;
struct EpiSwiGLU {
    static constexpr bool PERM = true, AFTER_DRAIN = false;
    bf16_t* O; int ldc; const float* rs;
    __device__ __forceinline__ void operator()(const f32x4 (&acc)[2][2][4][2], const Unit& u, int wr, int wc, int fr, int fq) const {
        const int row0 = u.pm * BM + wr * 64 + fr; const int col0 = u.pn * HALF + wc * 32 + 8 * fq;
        float rsv[2][4];
#pragma unroll
        for (int ai = 0; ai < 2; ++ai)
#pragma unroll
            for (int m = 0; m < 4; ++m) rsv[ai][m] = pss_lane(rs, row0 + ai * HALF + m * 16, fq);
#pragma unroll
        for (int ai = 0; ai < 2; ++ai)
#pragma unroll
            for (int m = 0; m < 4; ++m) rsv[ai][m] = rstd_fin(rsv[ai][m]);
#pragma unroll
        for (int ai = 0; ai < 2; ++ai)
#pragma unroll
            for (int m = 0; m < 4; ++m) { bf16_t* rowp = O + (size_t)(row0 + ai * HALF + m * 16) * ldc + col0;
                const float rsc = rsv[ai][m];
                float h[8], gg[8], uu[8], ee[8];
#pragma unroll
                for (int q = 0; q < 8; ++q) { gg[q] = acc[ai][0][m][q >> 2][q & 3] * rsc; uu[q] = acc[ai][1][m][q >> 2][q & 3] * rsc; }
#pragma unroll
                for (int q = 0; q < 8; ++q) ee[q] = fast_exp2(-1.4426950408889634f * gg[q]);
#pragma unroll
                for (int q = 0; q < 8; ++q) uu[q] *= gg[q];
#pragma unroll
                for (int q = 0; q < 8; ++q) ee[q] = fast_rcp(1.0f + ee[q]);
#pragma unroll
                for (int q = 0; q < 8; ++q) h[q] = uu[q] * ee[q];
                u32x4 w; w.x = cvt_pk_bf16(h[0], h[1]); w.y = cvt_pk_bf16(h[2], h[3]); w.z = cvt_pk_bf16(h[4], h[5]); w.w = cvt_pk_bf16(h[6], h[7]);
                *(u32x4*)rowp = w; }
    }
};
struct EpiWin {
    static constexpr bool PERM = true, AFTER_DRAIN = false;
    bf16_t* O; int ldc; const int* pos; float qscale; const float* rs; bf16_t* QC;
    __device__ __forceinline__ void operator()(f32x4 (&acc)[2][2][4][2], const Unit& u, int wr, int wc, int fr, int fq) const {
        const int row0 = u.pm * BM + wr * 64 + fr; const int col0 = u.pn * BM + wc * 32 + 8 * fq;
        const bool rope = (u.pn == 4 || u.pn == 5);
        const float sc = (u.pn == 4) ? qscale : 1.0f;
        float rsv[2][4];
#pragma unroll
        for (int ai = 0; ai < 2; ++ai)
#pragma unroll
            for (int m = 0; m < 4; ++m) rsv[ai][m] = pss_lane(rs, row0 + ai * HALF + m * 16, fq);
#pragma unroll
        for (int ai = 0; ai < 2; ++ai)
#pragma unroll
            for (int m = 0; m < 4; ++m) rsv[ai][m] = sc * rstd_fin(rsv[ai][m]);
        if (rope && fq == 0) {
            int posv[2][4];
#pragma unroll
            for (int ai = 0; ai < 2; ++ai)
#pragma unroll
                for (int m = 0; m < 4; ++m) posv[ai][m] = pos[row0 + ai * HALF + m * 16];
#pragma unroll
            for (int ai = 0; ai < 2; ++ai)
#pragma unroll
                for (int m = 0; m < 4; ++m) {
                    const float p = (float)posv[ai][m];
                    const float invf[4] = {1.0f, 0.03760603093086394f, 0.0014142135623730951f, 5.318295896944989e-05f};
                    float cs[4], sn[4];
#pragma unroll
                    for (int i = 0; i < 4; ++i) { const float ang = p * invf[i];
                        const float fr_ = __builtin_amdgcn_fractf(ang * 0.15915494309189535f);
                        sn[i] = __builtin_amdgcn_sinf(fr_); cs[i] = __builtin_amdgcn_cosf(fr_); }
#pragma unroll
                    for (int bj = 0; bj < 2; ++bj) { const f32x4 x1 = acc[ai][bj][m][0], x2 = acc[ai][bj][m][1];
#pragma unroll
                        for (int i = 0; i < 4; ++i) { acc[ai][bj][m][0][i] = x1[i] * cs[i] - x2[i] * sn[i]; acc[ai][bj][m][1][i] = x2[i] * cs[i] + x1[i] * sn[i]; } }
                }
        }
#pragma unroll
        for (int ai = 0; ai < 2; ++ai)
#pragma unroll
            for (int m = 0; m < 4; ++m) { const int row = row0 + ai * HALF + m * 16; bf16_t* rowp = O + (size_t)row * ldc + col0;
                const float rsc = rsv[ai][m];
                bf16_t* cp = QC + (rope ? (size_t)(u.pn - 4) * 8 * 8192 * 64 : 0) + ((size_t)((row >> 13) * 4 + (wc >> 1)) * 8192 + (row & 8191)) * 64 + (wc & 1) * 32 + 8 * fq;
#pragma unroll
                for (int bj = 0; bj < 2; ++bj) { const f32x4 v0 = acc[ai][bj][m][0] * rsc, v1 = acc[ai][bj][m][1] * rsc;
                    u32x4 w; w.x = cvt_pk_bf16(v0[0], v0[1]); w.y = cvt_pk_bf16(v0[2], v0[3]); w.z = cvt_pk_bf16(v1[0], v1[1]); w.w = cvt_pk_bf16(v1[2], v1[3]);
                    if (rope) *(u32x4*)(cp + (size_t)bj * 2 * 8192 * 64) = w; else *(u32x4*)(rowp + bj * HALF) = w; } }
    }
};
struct EpiSoftmax {
    static constexpr bool PERM = true, AFTER_DRAIN = true;
    bf16_t* O; int ldc;
    __device__ __forceinline__ void fused(f32x4 (&acc)[2][2][4][2], const Unit& u, int wr, int wc, int fr, int fq, LAS unsigned char* lds, int wid, int lane) const {
        LAS float* Pm = (LAS float*)lds; LAS float* Ps = (LAS float*)(lds + 4096);
#pragma unroll
        for (int ai = 0; ai < 2; ++ai)
#pragma unroll
            for (int m = 0; m < 4; ++m) { float v = -INFINITY;
#pragma unroll
                for (int bj = 0; bj < 2; ++bj)
#pragma unroll
                    for (int n = 0; n < 2; ++n) { const f32x4 x = acc[ai][bj][m][n]; v = fmaxf(v, fmaxf(fmaxf(x[0], x[1]), fmaxf(x[2], x[3]))); }
                v = fmaxf(v, shx<16>(v)); v = max32(v);
                if (fq == 0) Pm[(ai * HALF + wr * 64 + m * 16 + fr) * 4 + wc] = v; }
        __syncthreads();
#pragma unroll
        for (int ai = 0; ai < 2; ++ai)
#pragma unroll
            for (int m = 0; m < 4; ++m) { const int row = ai * HALF + wr * 64 + m * 16 + fr; const f32x4 t = *(const LAS f32x4*)(Pm + row * 4);
                const float mx = fmaxf(fmaxf(t[0], t[1]), fmaxf(t[2], t[3])); float s = 0.f;
#pragma unroll
                for (int bj = 0; bj < 2; ++bj)
#pragma unroll
                    for (int n = 0; n < 2; ++n)
#pragma unroll
                        for (int j = 0; j < 4; ++j) acc[ai][bj][m][n][j] = fast_exp2(acc[ai][bj][m][n][j] - mx);
#pragma unroll
                for (int bj = 0; bj < 2; ++bj)
#pragma unroll
                    for (int n = 0; n < 2; ++n) { const f32x4 x = acc[ai][bj][m][n]; s += (x[0] + x[1]) + (x[2] + x[3]); }
                {
                s += shx<16>(s); s = sum32(s);
                if (fq == 0) Ps[row * 4 + wc] = s; } }
        __syncthreads();
        const int col0 = u.pn * BM + wc * 32 + 8 * fq;
#pragma unroll
        for (int ai = 0; ai < 2; ++ai)
#pragma unroll
            for (int m = 0; m < 4; ++m) { const int row = ai * HALF + wr * 64 + m * 16 + fr; const f32x4 t = *(const LAS f32x4*)(Ps + row * 4);
                const float inv = 1.0f / ((t[0] + t[1]) + (t[2] + t[3]));
                bf16_t* rowp = O + (size_t)(u.pm * BM + row) * ldc + col0;
#pragma unroll
                for (int bj = 0; bj < 2; ++bj) { const f32x4 v0 = acc[ai][bj][m][0] * inv, v1 = acc[ai][bj][m][1] * inv;
                    u32x4 w; w.x = cvt_pk_bf16(v0[0], v0[1]); w.y = cvt_pk_bf16(v0[2], v0[3]); w.z = cvt_pk_bf16(v1[0], v1[1]); w.w = cvt_pk_bf16(v1[2], v1[3]);
                    *(u32x4*)(rowp + bj * HALF) = w; } }
        __syncthreads();
    }
};


__device__ __forceinline__ void panel_exchange(const float (&part)[2][4], float* slotbuf, unsigned* cntw, unsigned want, int pm, int pn, int wr, int wc, int fr, int fq, LAS unsigned char* lds, int wid, int lane) {
    LAS float* P = (LAS float*)lds; LAS float* S = (LAS float*)(lds + 8192);
    if (fq == 0) {
#pragma unroll
        for (int ai = 0; ai < 2; ++ai)
#pragma unroll
            for (int m = 0; m < 4; ++m) P[(ai * HALF + wr * 64 + m * 16 + fr) * 4 + wc] = part[ai][m];
    }
    __syncthreads();
    const int tid = wid * 64 + lane;
    if (tid < 256) { const f32x4 t = *(const LAS f32x4*)(P + tid * 4);
        __hip_atomic_store(slotbuf + ((size_t)(pm * BM + tid)) * 4 + pn, (t.x + t.y) + (t.z + t.w), __ATOMIC_RELAXED, __HIP_MEMORY_SCOPE_AGENT); }
    asm volatile("s_waitcnt vmcnt(0)" ::: "memory");
    if (wid < 4 && lane == 0) __hip_atomic_fetch_add(cntw, 1u, __ATOMIC_RELAXED, __HIP_MEMORY_SCOPE_AGENT);
    if (wid == 0) {
        unsigned sp = 0;
        while ((unsigned)__builtin_amdgcn_readfirstlane(__hip_atomic_load(cntw, __ATOMIC_RELAXED, __HIP_MEMORY_SCOPE_AGENT)) < want) { __builtin_amdgcn_s_sleep(2); if (++sp > (1u << 22)) break; }
    }
    asm volatile("s_waitcnt vmcnt(0) lgkmcnt(0)" ::: "memory"); __syncthreads();
    if (tid < 256) { const float* sl = slotbuf + ((size_t)(pm * BM + tid)) * 4;
        f32x4 q; asm volatile("global_load_dwordx4 %0, %1, off sc1\n\ts_waitcnt vmcnt(0)" : "=&v"(q) : "v"(sl) : "memory");
        S[tid] = (q.x + q.y) + (q.z + q.w); }
    __syncthreads();
}
template <bool FINAL> struct EpiRes {
    static constexpr bool PERM = true, AFTER_DRAIN = true;
    bf16_t* XB; const float* gpost; float wgt; float* rstd; float* outf; float* slots; unsigned* cnt; unsigned xk;
    __device__ __forceinline__ void fused(f32x4 (&acc)[2][2][4][2], const Unit& u, int wr, int wc, int fr, int fq, LAS unsigned char* lds, int wid, int lane) const {
        const LAS float* S = (const LAS float*)(lds + 8192);
        const int col0 = u.pn * BM + wc * 32 + 8 * fq;
        u32x4 xres[2][4][2]; f32x4 gv[2][2];
#pragma unroll
        for (int ai = 0; ai < 2; ++ai)
#pragma unroll
            for (int m = 0; m < 4; ++m)
#pragma unroll
                for (int bj = 0; bj < 2; ++bj) xres[ai][m][bj] = *(const u32x4*)(XB + (size_t)(u.pm * BM + ai * HALF + wr * 64 + m * 16 + fr) * 1024 + col0 + bj * HALF);
#pragma unroll
        for (int bj = 0; bj < 2; ++bj)
#pragma unroll
            for (int n = 0; n < 2; ++n) gv[bj][n] = *(const f32x4*)(gpost + col0 + bj * HALF + 4 * n);
        float part[2][4];
#pragma unroll
        for (int ai = 0; ai < 2; ++ai)
#pragma unroll
            for (int m = 0; m < 4; ++m) { float s = 0.f;
#pragma unroll
                for (int bj = 0; bj < 2; ++bj)
#pragma unroll
                    for (int n = 0; n < 2; ++n) { const f32x4 x = acc[ai][bj][m][n]; s += (x[0] * x[0] + x[1] * x[1]) + (x[2] * x[2] + x[3] * x[3]); }
                s += shx<16>(s); s = sum32(s); part[ai][m] = s; }
        panel_exchange(part, slots + (size_t)(xk & 1u) * 65536, cnt + 64 * u.pm, 16u * (xk + 1u), u.pm, u.pn, wr, wc, fr, fq, lds, wid, lane);
#pragma unroll
        for (int ai = 0; ai < 2; ++ai)
#pragma unroll
            for (int m = 0; m < 4; ++m) { const int row = ai * HALF + wr * 64 + m * 16 + fr; const float rs = wgt * __builtin_amdgcn_rsqf(S[row] * (1.0f / 1024.0f) + EPS);
                bf16_t* xp = XB + (size_t)(u.pm * BM + row) * 1024 + col0; float s2 = 0.f;
#pragma unroll
                for (int bj = 0; bj < 2; ++bj) { const u32x4 xw = xres[ai][m][bj];
                    const f32x4 x0 = (f32x4){bf_lo(xw.x), bf_hi(xw.x), bf_lo(xw.y), bf_hi(xw.y)}, x1 = (f32x4){bf_lo(xw.z), bf_hi(xw.z), bf_lo(xw.w), bf_hi(xw.w)};
                    const f32x4 v0 = x0 + acc[ai][bj][m][0] * gv[bj][0] * rs, v1 = x1 + acc[ai][bj][m][1] * gv[bj][1] * rs;
                    if constexpr (FINAL) { float* op = outf + (size_t)(u.pm * BM + row) * 1024 + col0 + bj * HALF; *(f32x4*)op = v0; *(f32x4*)(op + 4) = v1; }
                    else { u32x4 w; w.x = cvt_pk_bf16(v0[0], v0[1]); w.y = cvt_pk_bf16(v0[2], v0[3]); w.z = cvt_pk_bf16(v1[0], v1[1]); w.w = cvt_pk_bf16(v1[2], v1[3]);
                        *(u32x4*)(xp + bj * HALF) = w;
                        const float a0 = bf_lo(w.x), a1 = bf_hi(w.x), a2 = bf_lo(w.y), a3 = bf_hi(w.y), a4 = bf_lo(w.z), a5 = bf_hi(w.z), a6 = bf_lo(w.w), a7 = bf_hi(w.w);
                        s2 += ((a0 * a0 + a1 * a1) + (a2 * a2 + a3 * a3)) + ((a4 * a4 + a5 * a5) + (a6 * a6 + a7 * a7)); } }
                if constexpr (!FINAL) { s2 += shx<16>(s2); s2 = sum32(s2); part[ai][m] = s2; } }
        if constexpr (!FINAL) {
            LAS float* P = (LAS float*)lds;
            if (fq == 0) {
#pragma unroll
                for (int ai = 0; ai < 2; ++ai)
#pragma unroll
                    for (int m = 0; m < 4; ++m) P[(ai * HALF + wr * 64 + m * 16 + fr) * 4 + wc] = part[ai][m];
            }
            __syncthreads();
            const int tid = wid * 64 + lane;
            if (tid < 256) { const f32x4 t = *(const LAS f32x4*)(P + tid * 4); rstd[((size_t)(u.pm * BM + tid)) * 4 + u.pn] = (t.x + t.y) + (t.z + t.w); }
            __syncthreads();
        }
    }
};

template <class Epi, class Sched, bool ALIGN_EPI = false, bool SP2 = false>
__device__ __forceinline__ void gemm_phase(LAS unsigned char* lds, const Gemm g, const Sched S, const Epi E, int wid0) {
    int tid = wid0 * 64 + lane_id(); asm volatile("" : "+v"(tid));
    const int wid = __builtin_amdgcn_readfirstlane(tid >> 6), lane = tid & 63, wr = wid >> 2, wc = wid & 3, fr = lane & 15, fq = lane >> 4;
    const int K = g.K, nt = K / BK;
    unsigned voffA[2], voffB[2];
#pragma unroll
    for (int i = 0; i < 2; ++i) { int R, C; stage_rc(tid * 16 + i * 8192, R, C); const int Rb = Epi::PERM ? ((R & ~31) + perm32(R & 31)) : R;
        voffA[i] = (unsigned)(R * g.lda + C) * 2u; voffB[i] = (unsigned)(Rb * g.ldb + C) * 2u; }
    const size_t kstep = (size_t)(BK * 2);
    const size_t hstepA = (size_t)HALF * g.lda * 2, hstepB = (size_t)HALF * g.ldb * 2;
    const unsigned ldsw = (unsigned)wid * 1024u;
    const int aoff = lds_byte(wr * 64 + fr, fq * 8), boff = lds_byte(wc * 32 + fr, fq * 8);
#define PG8_UA(u) ((const char*)g.A + 2 * ((long)(u).pm * g.a_pm + (long)(u).pn * g.a_pn))
#define PG8_UB(u) ((const char*)g.Bt + 2 * ((long)(u).pn * g.b_pn + (long)((u).pm >> g.bshift) * g.b_pb))
#define PG8_SA(b, h) (((b) * 2 + (h)) * HTB)
#define PG8_SB(b, h) ((4 + (b) * 2 + (h)) * HTB)
#define PG8_STAGE(bufoff, gbase, voff) do { _Pragma("unroll") for (int _i = 0; _i < 2; ++_i) \
        __builtin_amdgcn_global_load_lds((const unsigned*)((const char*)(gbase) + (voff)[_i]), (LAS unsigned*)(lds + (bufoff) + ldsw + _i * 8192), 16, 0, 0); } while (0)
#define PG8_LDA(dst, b, h) do { _Pragma("unroll") for (int m = 0; m < 4; ++m) _Pragma("unroll") for (int k = 0; k < 2; ++k) dst[m][k] = *(const LAS bf16x8*)(lds + PG8_SA(b, h) + aoff + m * 2048 + k * 1024); } while (0)
#define PG8_LDB(dst, b, h) do { _Pragma("unroll") for (int n = 0; n < 2; ++n) _Pragma("unroll") for (int k = 0; k < 2; ++k) dst[n][k] = *(const LAS bf16x8*)(lds + PG8_SB(b, h) + boff + n * 2048 + k * 1024); } while (0)
#define PG8_MMA(ai, bj, At, Bt) do { __builtin_amdgcn_s_setprio(1); _Pragma("unroll") for (int m = 0; m < 4; ++m) _Pragma("unroll") for (int n = 0; n < 2; ++n) _Pragma("unroll") for (int k = 0; k < 2; ++k) \
        acc[ai][bj][m][n] = __builtin_amdgcn_mfma_f32_16x16x32_bf16(Bt[n][k], At[m][k], acc[ai][bj][m][n], 0, 0, 0); __builtin_amdgcn_s_setprio(0); } while (0)
#define PG8_WAIT_V(n) asm volatile("s_waitcnt vmcnt(" #n ")" ::: "memory")
#define PG8_WAIT_L(n) asm volatile("s_waitcnt lgkmcnt(" #n ")" ::: "memory")
#define PG8_BAR __builtin_amdgcn_s_barrier()
#define PG8_SCHED __builtin_amdgcn_sched_barrier(0)
    Unit cur, nxt; int ui = 0;
    if (!S.next(0, cur)) return;
    f32x4 acc[2][2][4][2];
#pragma unroll
    for (int a = 0; a < 2; ++a)
#pragma unroll
        for (int b = 0; b < 2; ++b)
#pragma unroll
            for (int m = 0; m < 4; ++m)
#pragma unroll
                for (int n = 0; n < 2; ++n) acc[a][b][m][n] = (f32x4){0.f, 0.f, 0.f, 0.f};
    bf16x8 At[4][2], B0[2][2], B1[2][2];
    const char* cA = PG8_UA(cur); const char* cB = PG8_UB(cur);
    if constexpr (SP2) {
        PG8_STAGE(PG8_SB(0, 0), cB, voffB); PG8_STAGE(PG8_SB(0, 1), cB + hstepB, voffB); PG8_STAGE(PG8_SA(0, 0), cA, voffA); PG8_STAGE(PG8_SA(0, 1), cA + hstepA, voffA);
        if (wr == 1) PG8_BAR;
        PG8_WAIT_V(2); PG8_BAR;
        PG8_STAGE(PG8_SB(1, 0), cB + kstep, voffB); PG8_STAGE(PG8_SA(1, 0), cA + kstep, voffA); PG8_STAGE(PG8_SB(1, 1), cB + hstepB + kstep, voffB);
        PG8_WAIT_V(6); PG8_BAR;
    } else {
        PG8_STAGE(PG8_SB(0, 0), cB, voffB); PG8_STAGE(PG8_SA(0, 0), cA, voffA); PG8_STAGE(PG8_SB(0, 1), cB + hstepB, voffB); PG8_STAGE(PG8_SA(0, 1), cA + hstepA, voffA);
        if (wr == 1) PG8_BAR;
        PG8_WAIT_V(4); PG8_BAR;
        PG8_STAGE(PG8_SB(1, 0), cB + kstep, voffB); PG8_STAGE(PG8_SA(1, 0), cA + kstep, voffA); PG8_STAGE(PG8_SB(1, 1), cB + hstepB + kstep, voffB);
        PG8_WAIT_V(6); PG8_BAR;
    }
    for (;;) {
        const bool has_next = S.next(ui + 1, nxt);
        const char* nA = has_next ? PG8_UA(nxt) : cA; const char* nB = has_next ? PG8_UB(nxt) : cB;
        for (int t = 0; t < nt; t += 2) {
            const bool last = (t == nt - 2);
            const char* a1 = cA + (size_t)(t + 1) * kstep;
            const char* a2 = last ? nA : cA + (size_t)(t + 2) * kstep; const char* b2 = last ? nB : cB + (size_t)(t + 2) * kstep;
            const char* a3 = a2 + kstep; const char* b3 = b2 + kstep;
            if constexpr (SP2) {
            PG8_LDB(B0, 0, 0); PG8_LDB(B1, 0, 1); PG8_SCHED; PG8_LDA(At, 0, 0); PG8_STAGE(PG8_SA(1, 1), a1 + hstepA, voffA);
            PG8_WAIT_V(8); PG8_WAIT_L(0); PG8_BAR; PG8_MMA(0, 0, At, B0); PG8_MMA(0, 1, At, B1); PG8_BAR; PG8_SCHED;
            PG8_LDA(At, 0, 1); PG8_STAGE(PG8_SB(0, 0), b2, voffB); PG8_STAGE(PG8_SB(0, 1), b2 + hstepB, voffB); PG8_STAGE(PG8_SA(0, 0), a2, voffA);
            PG8_WAIT_V(8); PG8_WAIT_L(0); PG8_BAR; PG8_MMA(1, 0, At, B0); PG8_MMA(1, 1, At, B1); PG8_BAR; PG8_SCHED;
            PG8_LDB(B0, 1, 0); PG8_LDB(B1, 1, 1); PG8_SCHED; PG8_LDA(At, 1, 0); PG8_STAGE(PG8_SA(0, 1), a2 + hstepA, voffA);
            PG8_WAIT_V(8); PG8_WAIT_L(0); PG8_BAR; PG8_MMA(0, 0, At, B0); PG8_MMA(0, 1, At, B1); PG8_BAR; PG8_SCHED;
            PG8_LDA(At, 1, 1); PG8_STAGE(PG8_SB(1, 0), b3, voffB); PG8_STAGE(PG8_SB(1, 1), b3 + hstepB, voffB); PG8_STAGE(PG8_SA(1, 0), a3, voffA);
            PG8_WAIT_V(8); PG8_WAIT_L(0); PG8_BAR; PG8_MMA(1, 0, At, B0); PG8_MMA(1, 1, At, B1); PG8_BAR; PG8_SCHED;
            } else {
            PG8_LDB(B0, 0, 0); PG8_SCHED; PG8_LDA(At, 0, 0); PG8_STAGE(PG8_SA(1, 1), a1 + hstepA, voffA);
            PG8_WAIT_L(8); PG8_BAR; PG8_WAIT_L(0); PG8_MMA(0, 0, At, B0); PG8_BAR; PG8_SCHED;
            PG8_LDB(B1, 0, 1); PG8_STAGE(PG8_SB(0, 0), b2, voffB);
            PG8_BAR; PG8_WAIT_L(0); PG8_MMA(0, 1, At, B1); PG8_BAR;
            PG8_LDA(At, 0, 1); PG8_STAGE(PG8_SA(0, 0), a2, voffA);
            PG8_BAR; PG8_WAIT_L(0); PG8_MMA(1, 0, At, B0); PG8_BAR; PG8_SCHED;
            PG8_STAGE(PG8_SB(0, 1), b2 + hstepB, voffB);
            PG8_WAIT_V(6); PG8_BAR; PG8_MMA(1, 1, At, B1); PG8_BAR;
            PG8_LDB(B0, 1, 0); PG8_SCHED; PG8_LDA(At, 1, 0); PG8_STAGE(PG8_SA(0, 1), a2 + hstepA, voffA);
            PG8_WAIT_L(8); PG8_BAR; PG8_WAIT_L(0); PG8_MMA(0, 0, At, B0); PG8_BAR; PG8_SCHED;
            PG8_LDB(B1, 1, 1); PG8_STAGE(PG8_SB(1, 0), b3, voffB);
            PG8_BAR; PG8_WAIT_L(0); PG8_MMA(0, 1, At, B1); PG8_BAR;
            PG8_LDA(At, 1, 1); PG8_STAGE(PG8_SA(1, 0), a3, voffA);
            PG8_BAR; PG8_WAIT_L(0); PG8_MMA(1, 0, At, B0); PG8_BAR; PG8_SCHED;
            PG8_STAGE(PG8_SB(1, 1), b3 + hstepB, voffB);
            PG8_WAIT_V(6); PG8_BAR; PG8_MMA(1, 1, At, B1); PG8_BAR;
            }
        }
        if constexpr (ALIGN_EPI) { if (wr == 0) PG8_BAR; }
        if constexpr (!Epi::AFTER_DRAIN) { E(acc, cur, wr, wc, fr, fq); }
        if (!has_next) break;
#pragma unroll
        for (int a = 0; a < 2; ++a)
#pragma unroll
            for (int b = 0; b < 2; ++b)
#pragma unroll
                for (int m = 0; m < 4; ++m)
#pragma unroll
                    for (int n = 0; n < 2; ++n) acc[a][b][m][n] = (f32x4){0.f, 0.f, 0.f, 0.f};
        cur = nxt; cA = nA; cB = nB; ++ui;
        if constexpr (ALIGN_EPI) { if (wr == 1) PG8_BAR; }
    }
    PG8_WAIT_V(0);
    if constexpr (!ALIGN_EPI) { if (wr == 0) PG8_BAR; }
    PG8_BAR;
    if constexpr (Epi::AFTER_DRAIN) { E.fused(acc, cur, wr, wc, fr, fq, lds, wid, lane); }
#undef PG8_UA
#undef PG8_UB
#undef PG8_SA
#undef PG8_SB
#undef PG8_STAGE
#undef PG8_LDA
#undef PG8_LDB
#undef PG8_MMA
#undef PG8_WAIT_V
#undef PG8_WAIT_L
#undef PG8_BAR
#undef PG8_SCHED
}
}

struct TItem { const float* W; bf16_t* WT; const float* gk; int K, N, drow0, k0, n0; bool valid; };
__device__ __forceinline__ void ti_load(const TItem& t, f32x4 (&v)[16], int lane) {
    const int lr = lane >> 4, lc = (lane & 15) * 4;
    if (t.valid) {
#pragma unroll
        for (int i = 0; i < 16; ++i) v[i] = *(const f32x4*)(t.W + (size_t)(t.k0 + 4 * i + lr) * t.N + t.n0 + lc);
    }
}
__device__ __forceinline__ void ti_finish(const TItem& t, f32x4 (&v)[16], LAS float* scr, int lane) {
    if (!t.valid) return;
    const int lr = lane >> 4, lc = (lane & 15) * 4;
    const int c = lane & 7;
    f32x4 g0 = (f32x4){1.f, 1.f, 1.f, 1.f}, g1 = g0;
    if (t.gk) { g0 = *(const f32x4*)(t.gk + t.k0 + 8 * c); g1 = *(const f32x4*)(t.gk + t.k0 + 8 * c + 4); }
#pragma unroll
    for (int i = 0; i < 16; ++i) { LAS float* s = scr + (4 * i + lr) * 65 + lc; s[0] = v[i].x; s[1] = v[i].y; s[2] = v[i].z; s[3] = v[i].w; }
    asm volatile("s_waitcnt lgkmcnt(0)" ::: "memory");
#pragma unroll
    for (int j = 0; j < 8; ++j) { const int n = (lane >> 3) + 8 * j; const LAS float* s = scr + (8 * c) * 65 + n;
        u32x4 o; o.x = cvt_pk_bf16(s[0 * 65] * g0.x, s[1 * 65] * g0.y); o.y = cvt_pk_bf16(s[2 * 65] * g0.z, s[3 * 65] * g0.w); o.z = cvt_pk_bf16(s[4 * 65] * g1.x, s[5 * 65] * g1.y); o.w = cvt_pk_bf16(s[6 * 65] * g1.z, s[7 * 65] * g1.w);
        *(u32x4*)(t.WT + (size_t)(t.drow0 + n) * t.K + t.k0 + 8 * c) = o; }
    asm volatile("s_waitcnt lgkmcnt(0)" ::: "memory");
}

template <bool HAS_Y, bool HAS_XN>
__device__ __forceinline__ void rowpass(const float* xin, float* xout, const bf16_t* Y, const float* gpost, float wgt, bf16_t* XN, const float* gpre, int nrows, int gw, int NGW, int lane_in) {
    int lane = lane_in; asm volatile("" : "+v"(lane));
    for (int m = gw; m < nrows; m += NGW) {
        const f32x4* xr = (const f32x4*)(xin + (size_t)m * DM) + lane;
        f32x4 v[4];
#pragma unroll
        for (int j = 0; j < 4; ++j) v[j] = xr[64 * j];
        if constexpr (HAS_Y) {
            const u32x2* yr = (const u32x2*)(Y + (size_t)m * DM) + lane;
            f32x4 y[4]; float ss = 0.f;
#pragma unroll
            for (int j = 0; j < 4; ++j) { const u32x2 w = yr[64 * j]; y[j] = (f32x4){bf_lo(w.x), bf_hi(w.x), bf_lo(w.y), bf_hi(w.y)};
                ss += (y[j].x * y[j].x + y[j].y * y[j].y) + (y[j].z * y[j].z + y[j].w * y[j].w); }
            ss = wave_sum(ss);
            const float rs = wgt / sqrtf(ss * (1.0f / DM) + EPS);
#pragma unroll
            for (int j = 0; j < 4; ++j) { const f32x4 g = ((const f32x4*)gpost)[lane + 64 * j]; v[j] = v[j] + y[j] * g * rs; }
        }
        if (xout) { f32x4* xo = (f32x4*)(xout + (size_t)m * DM) + lane;
#pragma unroll
            for (int j = 0; j < 4; ++j) xo[64 * j] = v[j]; }
        if constexpr (HAS_XN) {
            float s2 = 0.f;
#pragma unroll
            for (int j = 0; j < 4; ++j) s2 += (v[j].x * v[j].x + v[j].y * v[j].y) + (v[j].z * v[j].z + v[j].w * v[j].w);
            s2 = wave_sum(s2);
            const float rs2 = 1.0f / sqrtf(s2 * (1.0f / DM) + EPS);
            u32x2* xo = (u32x2*)(XN + (size_t)m * DM) + lane;
#pragma unroll
            for (int j = 0; j < 4; ++j) { const f32x4 g = ((const f32x4*)gpre)[lane + 64 * j]; const f32x4 o = v[j] * g * rs2;
                u32x2 w; w.x = cvt_pk_bf16(o.x, o.y); w.y = cvt_pk_bf16(o.z, o.w); xo[64 * j] = w; }
        }
    }
}

__device__ __forceinline__ void rowpass0(const float* xin, bf16_t* XB, float* rstd, int gw, int NGW, int lane_in) {
    int lane = lane_in; asm volatile("" : "+v"(lane));
    for (int m = gw; m < NTOK; m += 2 * NGW) {
        const int m2 = m + NGW;
        const f32x4* xr = (const f32x4*)(xin + (size_t)m * DM) + lane; const f32x4* xr2 = (const f32x4*)(xin + (size_t)m2 * DM) + lane;
        f32x4 va[4], vb[4];
#pragma unroll
        for (int j = 0; j < 4; ++j) { va[j] = xr[64 * j]; vb[j] = xr2[64 * j]; }
        u32x2* xo = (u32x2*)(XB + (size_t)m * DM) + lane; u32x2* xo2 = (u32x2*)(XB + (size_t)m2 * DM) + lane;
        float s2 = 0.f, t2 = 0.f;
#pragma unroll
        for (int j = 0; j < 4; ++j) {
            u32x2 w; w.x = cvt_pk_bf16(va[j].x, va[j].y); w.y = cvt_pk_bf16(va[j].z, va[j].w); xo[64 * j] = w;
            { const float a = bf_lo(w.x), b = bf_hi(w.x), c = bf_lo(w.y), d = bf_hi(w.y); s2 += (a * a + b * b) + (c * c + d * d); }
            u32x2 w2; w2.x = cvt_pk_bf16(vb[j].x, vb[j].y); w2.y = cvt_pk_bf16(vb[j].z, vb[j].w); xo2[64 * j] = w2;
            { const float a = bf_lo(w2.x), b = bf_hi(w2.x), c = bf_lo(w2.y), d = bf_hi(w2.y); t2 += (a * a + b * b) + (c * c + d * d); }
        }
        s2 = wave_sum(s2); t2 = wave_sum(t2);
        if (lane == 0) { *(f32x4*)(rstd + 4 * (size_t)m) = (f32x4){s2, 0.f, 0.f, 0.f}; *(f32x4*)(rstd + 4 * (size_t)m2) = (f32x4){t2, 0.f, 0.f, 0.f}; }
    }
}
__device__ __forceinline__ void wave_sum8(float (&v)[8]) {
#pragma unroll
    for (int i = 0; i < 8; ++i) v[i] += shx<1>(v[i]);
#pragma unroll
    for (int i = 0; i < 8; ++i) v[i] += shx<2>(v[i]);
#pragma unroll
    for (int i = 0; i < 8; ++i) v[i] += shx<4>(v[i]);
#pragma unroll
    for (int i = 0; i < 8; ++i) v[i] += shx<8>(v[i]);
#pragma unroll
    for (int i = 0; i < 8; ++i) v[i] += shx<16>(v[i]);
#pragma unroll
    for (int i = 0; i < 8; ++i) v[i] = sum32(v[i]);
}
__device__ __forceinline__ void light_mixers_tile(LAS unsigned char* lds, const bf16_t* Z, bf16_t* YC, int tl, const float* pool_w, const float* pool_scale, const float* sconv_w,
                                                  const float* dw_w, const float* dw_b, const float* ln_g, const float* ln_b, int wid0) {
    int tid = wid0 * 64 + lane_id(); asm volatile("" : "+v"(tid));
    const int lane = tid & 63, wid = tid >> 6;
    const int tok0 = tl * 64, s0 = tok0 % SEQ;
    float scw[3][8];
#pragma unroll
    for (int j = 0; j < 3; ++j)
#pragma unroll
        for (int i = 0; i < 8; ++i) scw[j][i] = sconv_w[j * 256 + (tid & 31) * 8 + i];
    u32x4 sco[4];
#pragma unroll
    for (int k = 0; k < 4; ++k) { const int it = tid + 512 * k;
        const int t = it >> 5, c8 = (it & 31) * 8; const int s = s0 + t; const bf16_t* zr = Z + (size_t)(tok0 + t) * ZLD;
        float xs[8], cgv[8], bg[8], p0[8], p1[8], p2[8];
        ld8(zr + 256 + c8, xs); ld8(zr + 768 + c8, cgv); ld8(zr + 512 + c8, bg);
#pragma unroll
        for (int i = 0; i < 8; ++i) p2[i] = xs[i] * cgv[i];
        if (s >= 1) { ld8(zr - ZLD + 256 + c8, xs); ld8(zr - ZLD + 768 + c8, cgv);
#pragma unroll
            for (int i = 0; i < 8; ++i) p1[i] = xs[i] * cgv[i]; }
        else {
#pragma unroll
            for (int i = 0; i < 8; ++i) p1[i] = 0.f; }
        if (s >= 2) { ld8(zr - 2 * ZLD + 256 + c8, xs); ld8(zr - 2 * ZLD + 768 + c8, cgv);
#pragma unroll
            for (int i = 0; i < 8; ++i) p0[i] = xs[i] * cgv[i]; }
        else {
#pragma unroll
            for (int i = 0; i < 8; ++i) p0[i] = 0.f; }
        float o[8];
#pragma unroll
        for (int i = 0; i < 8; ++i) o[i] = bg[i] * (scw[0][i] * p0[i] + scw[1][i] * p1[i] + scw[2][i] * p2[i]);
        u32x4 w; w.x = cvt_pk_bf16(o[0], o[1]); w.y = cvt_pk_bf16(o[2], o[3]); w.z = cvt_pk_bf16(o[4], o[5]); w.w = cvt_pk_bf16(o[6], o[7]);
        sco[k] = w;
    }
#pragma unroll
    for (int k = 0; k < 4; ++k) { const int it = tid + 512 * k; *(u32x4*)(YC + (size_t)(tok0 + (it >> 5)) * DM + 256 + (it & 31) * 8) = sco[k]; }
    LAS bf16_t* mxb = (LAS bf16_t*)lds;
    LAS bf16_t* wtb = (LAS bf16_t*)(lds + 34816);
    LAS bf16_t* zb = (LAS bf16_t*)(lds + 73728);
    {   u32x4 zr5[5];
#pragma unroll
        for (int k = 0; k < 5; ++k) { const int it = tid + 512 * k; const int i = it >> 5, c8 = (it & 31) * 8; const int s = s0 - 15 + i;
            zr5[k] = (u32x4){0u, 0u, 0u, 0u};
            if (it < 79 * 32 && s >= 0) zr5[k] = *(const u32x4*)(Z + (size_t)(tok0 - 15 + i) * ZLD + c8); }
#pragma unroll
        for (int k = 0; k < 5; ++k) { const int it = tid + 512 * k; if (it < 79 * 32) *(LAS u32x4*)(zb + (it >> 5) * 256 + (it & 31) * 8) = zr5[k]; }
    }
#pragma unroll
    for (int e0 = 0; e0 < 16384; e0 += 512 * 8) {
        float pw[8];
#pragma unroll
        for (int k = 0; k < 8; ++k) pw[k] = pool_w[e0 + 512 * k + tid];
#pragma unroll
        for (int k = 0; k < 8; ++k) { const int e = e0 + 512 * k + tid; const int g = e >> 12, c = (e >> 6) & 63, d = e & 63; wtb[(g * 64 + d) * 72 + c] = (bf16_t)(cvt_pk_bf16(pw[k], 0.f) & 0xffffu); }
    }
    __syncthreads();
    for (int it = tid; it < 64 * 32; it += 512) {
        const int t = it >> 5, c8 = (it & 31) * 8; const int s = s0 + t; const int g = c8 >> 6, w = 2 << g; const int cnt = (s + 1 < w) ? (s + 1) : w;
        float cur[8], sum[8];
        { const u32x4 q = *(const LAS u32x4*)(zb + (15 + t) * 256 + c8);
          cur[0] = bf_lo(q.x); cur[1] = bf_hi(q.x); cur[2] = bf_lo(q.y); cur[3] = bf_hi(q.y); cur[4] = bf_lo(q.z); cur[5] = bf_hi(q.z); cur[6] = bf_lo(q.w); cur[7] = bf_hi(q.w); }
#pragma unroll
        for (int i = 0; i < 8; ++i) sum[i] = cur[i];
        for (int j = 1; j < w; ++j) { const u32x4 q = *(const LAS u32x4*)(zb + (15 + t - j) * 256 + c8);
            sum[0] += bf_lo(q.x); sum[1] += bf_hi(q.x); sum[2] += bf_lo(q.y); sum[3] += bf_hi(q.y); sum[4] += bf_lo(q.z); sum[5] += bf_hi(q.z); sum[6] += bf_lo(q.w); sum[7] += bf_hi(q.w); }
        const float ic = 1.0f / (float)cnt;
        u32x4 o; o.x = cvt_pk_bf16(sum[0] * ic - cur[0], sum[1] * ic - cur[1]); o.y = cvt_pk_bf16(sum[2] * ic - cur[2], sum[3] * ic - cur[3]);
        o.z = cvt_pk_bf16(sum[4] * ic - cur[4], sum[5] * ic - cur[5]); o.w = cvt_pk_bf16(sum[6] * ic - cur[6], sum[7] * ic - cur[7]);
        *(LAS u32x4*)(mxb + t * 264 + c8) = o;
    }
    __syncthreads();
    {
        const int g = wid >> 1, tb = wid & 1, r32 = lane & 31, hi = lane >> 5;
        f32x16 acc0 = {}, acc1 = {};
#pragma unroll
        for (int ks = 0; ks < 4; ++ks) {
            const bf16x8 bm = *(const LAS bf16x8*)(mxb + (tb * 32 + r32) * 264 + g * 64 + ks * 16 + hi * 8);
            const bf16x8 a0 = *(const LAS bf16x8*)(wtb + (g * 64 + r32) * 72 + ks * 16 + hi * 8), a1 = *(const LAS bf16x8*)(wtb + (g * 64 + 32 + r32) * 72 + ks * 16 + hi * 8);
            acc0 = __builtin_amdgcn_mfma_f32_32x32x16_bf16(a0, bm, acc0, 0, 0, 0);
            acc1 = __builtin_amdgcn_mfma_f32_32x32x16_bf16(a1, bm, acc1, 0, 0, 0);
        }
        bf16_t* op = YC + (size_t)(tok0 + tb * 32 + r32) * DM + g * 64;
        f32x4 sav[4], sbv[4];
#pragma unroll
        for (int rg = 0; rg < 4; ++rg) { sav[rg] = *(const f32x4*)(pool_scale + g * 64 + 8 * rg + 4 * hi); sbv[rg] = *(const f32x4*)(pool_scale + g * 64 + 32 + 8 * rg + 4 * hi); }
#pragma unroll
        for (int rg = 0; rg < 4; ++rg) { const int d0 = 8 * rg + 4 * hi;
            const f32x4 sa = sav[rg], sb = sbv[rg];
            u32x2 wa, wb;
            wa.x = cvt_pk_bf16(acc0[4 * rg + 0] * sa.x, acc0[4 * rg + 1] * sa.y); wa.y = cvt_pk_bf16(acc0[4 * rg + 2] * sa.z, acc0[4 * rg + 3] * sa.w);
            wb.x = cvt_pk_bf16(acc1[4 * rg + 0] * sb.x, acc1[4 * rg + 1] * sb.y); wb.y = cvt_pk_bf16(acc1[4 * rg + 2] * sb.z, acc1[4 * rg + 3] * sb.w);
            *(u32x2*)(op + d0) = wa; *(u32x2*)(op + 32 + d0) = wb; }
    }
    __syncthreads();
    LAS bf16_t* ub = (LAS bf16_t*)lds; LAS float* cv = (LAS float*)(lds + 49152);
    {   u32x4 gaw[6], ggw[6];
#pragma unroll
        for (int k = 0; k < 6; ++k) { const int it = tid + 512 * k; const int i = it >> 5, c8 = (it & 31) * 8; const int s = s0 - 30 + i;
            gaw[k] = (u32x4){0u, 0u, 0u, 0u}; ggw[k] = gaw[k];
            if (it < 94 * 32 && s >= 0) { const bf16_t* zr = Z + (size_t)(tok0 - 30 + i) * ZLD; gaw[k] = *(const u32x4*)(zr + 1536 + c8); ggw[k] = *(const u32x4*)(zr + 1792 + c8); } }
#pragma unroll
        for (int k = 0; k < 6; ++k) { const int it = tid + 512 * k;
            float ga[8], gg[8], e[8];
            ga[0] = bf_lo(gaw[k].x); ga[1] = bf_hi(gaw[k].x); ga[2] = bf_lo(gaw[k].y); ga[3] = bf_hi(gaw[k].y); ga[4] = bf_lo(gaw[k].z); ga[5] = bf_hi(gaw[k].z); ga[6] = bf_lo(gaw[k].w); ga[7] = bf_hi(gaw[k].w);
            gg[0] = bf_lo(ggw[k].x); gg[1] = bf_hi(ggw[k].x); gg[2] = bf_lo(ggw[k].y); gg[3] = bf_hi(ggw[k].y); gg[4] = bf_lo(ggw[k].z); gg[5] = bf_hi(ggw[k].z); gg[6] = bf_lo(ggw[k].w); gg[7] = bf_hi(ggw[k].w);
#pragma unroll
            for (int q = 0; q < 8; ++q) e[q] = fast_exp2(-1.4426950408889634f * gg[q]);
#pragma unroll
            for (int q = 0; q < 8; ++q) e[q] = fast_rcp(1.0f + e[q]);
#pragma unroll
            for (int q = 0; q < 8; ++q) e[q] *= ga[q];
            u32x4 w; w.x = cvt_pk_bf16(e[0], e[1]); w.y = cvt_pk_bf16(e[2], e[3]); w.z = cvt_pk_bf16(e[4], e[5]); w.w = cvt_pk_bf16(e[6], e[7]);
            if (it < 94 * 32) *(LAS u32x4*)(ub + (it >> 5) * 256 + (it & 31) * 8) = w; }
    }
    __syncthreads();
    {
        const int ch = tid & 255, half = tid >> 8;
        float wt[31];
#pragma unroll
        for (int j = 0; j < 31; ++j) wt[j] = dw_w[j * 256 + ch];
        const float bias = dw_b[ch];
        float uu[62];
#pragma unroll
        for (int i = 0; i < 62; ++i) uu[i] = bf2f(ub[(half * 32 + i) * 256 + ch]);
#pragma unroll
        for (int t = 0; t < 32; ++t) {
            float a = bias;
#pragma unroll
            for (int j = 0; j < 31; ++j) a += wt[j] * uu[t + j];
            cv[(half * 32 + t) * 256 + ch] = a;
        }
    }
    __syncthreads();
    {
        const f32x4 g4 = ((const f32x4*)ln_g)[lane], b4 = ((const f32x4*)ln_b)[lane];
        f32x4 v[8]; float sm[8];
#pragma unroll
        for (int i = 0; i < 8; ++i) { v[i] = *(const LAS f32x4*)(cv + (wid * 8 + i) * 256 + 4 * lane); sm[i] = (v[i].x + v[i].y) + (v[i].z + v[i].w); }
        wave_sum8(sm);
#pragma unroll
        for (int i = 0; i < 8; ++i) { v[i] = v[i] - sm[i] * (1.0f / 256.0f); sm[i] = (v[i].x * v[i].x + v[i].y * v[i].y) + (v[i].z * v[i].z + v[i].w * v[i].w); }
        wave_sum8(sm);
        u32x2 ow[8];
#pragma unroll
        for (int i = 0; i < 8; ++i) { const float rs = __builtin_amdgcn_rsqf(sm[i] * (1.0f / 256.0f) + EPS);
            const f32x4 y = v[i] * rs * g4 + b4;
            float e0 = fast_exp2(-1.4426950408889634f * y.x), e1 = fast_exp2(-1.4426950408889634f * y.y), e2 = fast_exp2(-1.4426950408889634f * y.z), e3 = fast_exp2(-1.4426950408889634f * y.w);
            e0 = fast_rcp(1.0f + e0); e1 = fast_rcp(1.0f + e1); e2 = fast_rcp(1.0f + e2); e3 = fast_rcp(1.0f + e3);
            ow[i].x = cvt_pk_bf16(y.x * e0, y.y * e1); ow[i].y = cvt_pk_bf16(y.z * e2, y.w * e3); }
#pragma unroll
        for (int i = 0; i < 8; ++i) *(u32x2*)(YC + (size_t)(tok0 + wid * 8 + i) * DM + 768 + 4 * lane) = ow[i];
    }
    __syncthreads();
}

constexpr int DA_KST = 144, DA_VST = 272, DA_KB = 128 * DA_KST, DA_VB = 64 * DA_VST, DA_BUF = DA_KB + DA_VB;
__device__ __forceinline__ float fadd_s(float a, float b) { float r; asm("v_add_f32_e32 %0, %1, %2" : "=v"(r) : "v"(a), "v"(b)); return r; }
template <int NH, bool FIRST>
__device__ __forceinline__ float da_step(const LAS unsigned char* kb, int kroff, int vroff, const bf16x8 (&qr)[2], f32x16& o0, f32x16& o1, f32x16& osum, f32x16& negm, float& mhat) {
    const bf16x8 ones = (bf16x8){0x3F80, 0x3F80, 0x3F80, 0x3F80, 0x3F80, 0x3F80, 0x3F80, 0x3F80};
    float rmax = -INFINITY;
#pragma unroll
    for (int g = 0; g < NH; ++g) {
        const LAS unsigned char* kg = kb + kroff + g * 64 * DA_KST;
        const bf16x8 k0 = *(const LAS bf16x8*)(kg), k1 = *(const LAS bf16x8*)(kg + 32 * DA_KST);
        const bf16x8 k2 = *(const LAS bf16x8*)(kg + 32), k3 = *(const LAS bf16x8*)(kg + 32 * DA_KST + 32);
        f32x16 pa = __builtin_amdgcn_mfma_f32_32x32x16_bf16(k0, qr[0], negm, 0, 0, 0);
        f32x16 pc = __builtin_amdgcn_mfma_f32_32x32x16_bf16(k1, qr[0], negm, 0, 0, 0);
        pa = __builtin_amdgcn_mfma_f32_32x32x16_bf16(k2, qr[1], pa, 0, 0, 0);
        pc = __builtin_amdgcn_mfma_f32_32x32x16_bf16(k3, qr[1], pc, 0, 0, 0);
        bf16x8 vfa[2][2], vfb[2][2];
#pragma unroll
        for (int hh = 0; hh < 2; ++hh)
#pragma unroll
            for (int s = 0; s < 2; ++s) { const LAS unsigned char* vp = kb + DA_KB + vroff + (2 * g + hh) * 64 + s * 32;
                vfa[hh][s] = *(const LAS bf16x8*)(vp); vfb[hh][s] = *(const LAS bf16x8*)(vp + 32 * DA_VST); }
        __builtin_amdgcn_sched_barrier(0);
        if constexpr (FIRST) {
            if (g == 0) {
                float ra = fmaxf(fmaxf(pa[0], pa[1]), pc[0]), rb = fmaxf(fmaxf(pa[2], pa[3]), pc[1]);
                ra = fmaxf(fmaxf(ra, pc[2]), pc[3]);
#pragma unroll
                for (int r = 4; r < 16; r += 4) { ra = fmaxf(fmaxf(ra, pa[r]), pa[r + 1]); rb = fmaxf(fmaxf(rb, pa[r + 2]), pa[r + 3]); ra = fmaxf(fmaxf(ra, pc[r]), pc[r + 1]); rb = fmaxf(fmaxf(rb, pc[r + 2]), pc[r + 3]); }
                rmax = fmaxf(ra, rb);
            }
        }
        if constexpr (FIRST) {
            if (g == 0) {
                const float ra = max32(rmax); mhat = ra; rmax = 0.f;
#pragma unroll
                for (int r = 0; r < 16; ++r) { pa[r] -= ra; pc[r] -= ra; negm[r] = -mhat; }
            }
        }
#pragma unroll
        for (int r = 0; r < 16; r += 2) { pa[r] = fast_exp2(pa[r]); pa[r + 1] = fast_exp2(pa[r + 1]); }
#pragma unroll
        for (int r = 0; r < 16; r += 2) { pc[r] = fast_exp2(pc[r]); pc[r + 1] = fast_exp2(pc[r + 1]); }
        bf16x8 pb[2][2];
#pragma unroll
        for (int hh = 0; hh < 2; ++hh)
#pragma unroll
            for (int s = 0; s < 2; ++s) { const f32x16& q = hh ? pc : pa; u32x4 w;
                w.x = cvtpk_s(q[8 * s + 0], q[8 * s + 1]); w.y = cvtpk_s(q[8 * s + 2], q[8 * s + 3]); w.z = cvtpk_s(q[8 * s + 4], q[8 * s + 5]); w.w = cvtpk_s(q[8 * s + 6], q[8 * s + 7]);
                pb[hh][s] = __builtin_bit_cast(bf16x8, w); }
#pragma unroll
        for (int hh = 0; hh < 2; ++hh)
#pragma unroll
            for (int s = 0; s < 2; ++s) {
                o0 = __builtin_amdgcn_mfma_f32_32x32x16_bf16(vfa[hh][s], pb[hh][s], o0, 0, 0, 0);
                o1 = __builtin_amdgcn_mfma_f32_32x32x16_bf16(vfb[hh][s], pb[hh][s], o1, 0, 0, 0);
                osum = __builtin_amdgcn_mfma_f32_32x32x16_bf16(ones, pb[hh][s], osum, 0, 0, 0);
            }
    }
    return rmax;
}
__device__ __forceinline__ void dattn_unit(LAS unsigned char* lds, const bf16_t* QC, const bf16_t* VT, bf16_t* YC, int b, int h, int u128, float lam, float oscale, const float* subg, int wid0) {
    int tid = wid0 * 64 + lane_id(); asm volatile("" : "+v"(tid));
    const int lane = tid & 63, r32 = lane & 31, hi = lane >> 5; const int wid = __builtin_amdgcn_readfirstlane(tid >> 6);
    const int comp = wid >> 2, wq = wid & 3;
    const size_t tok0 = (size_t)b * SEQ; const int q0 = u128 * 128;
    const bf16_t* KC = QC + (size_t)8 * 8192 * 64;
    const bf16_t* qp = QC + ((size_t)(b * 4 + h) * 8192 + q0 + wq * 32 + r32) * 64 + comp * 32 + hi * 8;
    bf16x8 qr[2]; qr[0] = *(const bf16x8*)qp; qr[1] = *(const bf16x8*)(qp + 16);
    const int NS = u128 + 1;
    const int srow = tid >> 3, sch = tid & 7;
    const bf16_t* ksrc = KC + ((size_t)(b * 4 + h) * 8192 + srow) * 64 + sch * 8;
    const bf16_t* vsrc = VT + (size_t)(h * 64 + srow) * NTOK + tok0 + sch * 8;
    const int kwoff = srow * DA_KST + sch * 16, vwoff = DA_KB + srow * DA_VST + sch * 16;
    const int rsw = (r32 & 0x13) | ((r32 & 4) << 1) | ((r32 & 8) >> 1);
    const int kroff = rsw * DA_KST + comp * 64 + hi * 16;
    const int vroff = r32 * DA_VST + hi * 16;
    f32x16 o0 = {}, o1 = {}, osum = {}; float mhat = 0.f;
    f32x16 negm = {};
    {   const u32x4 k0 = *(const u32x4*)ksrc, k1 = *(const u32x4*)(ksrc + 64 * 64), v0 = *(const u32x4*)vsrc, v1 = *(const u32x4*)(vsrc + 64);
        *(LAS u32x4*)(lds + kwoff) = k0; *(LAS u32x4*)(lds + kwoff + 64 * DA_KST) = k1; *(LAS u32x4*)(lds + vwoff) = v0; *(LAS u32x4*)(lds + vwoff + 128) = v1; }
    __syncthreads();
    for (int s = 0; s < NS; ++s) {
        const bool more = (s + 1 < NS);
        u32x4 k0 = (u32x4){0u, 0u, 0u, 0u}, k1 = k0, v0 = k0, v1 = k0;
        if (more) { const bf16_t* kp = ksrc + (size_t)(s + 1) * 128 * 64; const bf16_t* vp = vsrc + (size_t)(s + 1) * 128;
            k0 = *(const u32x4*)kp; k1 = *(const u32x4*)(kp + 64 * 64); v0 = *(const u32x4*)vp; v1 = *(const u32x4*)(vp + 64); }
        const LAS unsigned char* kb = lds + (s & 1) * DA_BUF;
        if ((s & 1) == 0 && s > 0 && __builtin_expect(__any(osum[0] > 16777216.f), 0)) {
            asm volatile("" ::: "memory");
            const float dl = fmaxf(floorf(__log2f(fmaxf(osum[0], 1.0f))), 0.f); const float alpha = fast_exp2(-dl); mhat += dl;
#pragma unroll
            for (int r = 0; r < 16; ++r) { o0[r] *= alpha; o1[r] *= alpha; osum[r] *= alpha; negm[r] = -mhat; }
        }
        if (s == 0) { if (more || wq >= 2) (void)da_step<2, true>(kb, kroff, vroff, qr, o0, o1, osum, negm, mhat); else (void)da_step<1, true>(kb, kroff, vroff, qr, o0, o1, osum, negm, mhat); }
        else if (more || wq >= 2) (void)da_step<2, false>(kb, kroff, vroff, qr, o0, o1, osum, negm, mhat);
        else (void)da_step<1, false>(kb, kroff, vroff, qr, o0, o1, osum, negm, mhat);
        if (more) { LAS unsigned char* nb = lds + ((s + 1) & 1) * DA_BUF;
            *(LAS u32x4*)(nb + kwoff) = k0; *(LAS u32x4*)(nb + kwoff + 64 * DA_KST) = k1; *(LAS u32x4*)(nb + vwoff) = v0; *(LAS u32x4*)(nb + vwoff + 128) = v1; }
        __syncthreads();
    }
    const float inv = 1.0f / osum[0];
    LAS float* X = (LAS float*)lds;
    if (comp == 1) {
        const float f = inv * lam;
#pragma unroll
        for (int r = 0; r < 16; ++r) { X[((wq * 2 + 0) * 16 + r) * 64 + lane] = o0[r] * f; X[((wq * 2 + 1) * 16 + r) * 64 + lane] = o1[r] * f; }
    }
    __syncthreads();
    if (comp == 0) {
        float ss = 0.f;
#pragma unroll
        for (int r = 0; r < 16; ++r) { o0[r] = o0[r] * inv - X[((wq * 2 + 0) * 16 + r) * 64 + lane]; o1[r] = o1[r] * inv - X[((wq * 2 + 1) * 16 + r) * 64 + lane]; ss += o0[r] * o0[r] + o1[r] * o1[r]; }
        ss = sum32(ss);
        float li_ = oscale; asm volatile("" : "+v"(li_));
        const float rs = (1.0f - li_) / sqrtf(ss * (1.0f / 64.0f) + EPS);
        bf16_t* op = YC + (tok0 + q0 + wq * 32 + r32) * DM + 512 + h * 64;
        f32x4 gav[4], gbv[4];
#pragma unroll
        for (int rg = 0; rg < 4; ++rg) { gav[rg] = *(const f32x4*)(subg + 8 * rg + 4 * hi); gbv[rg] = *(const f32x4*)(subg + 32 + 8 * rg + 4 * hi); }
#pragma unroll
        for (int rg = 0; rg < 4; ++rg) {
            const int d0 = 8 * rg + 4 * hi;
            const f32x4 ga = gav[rg], gb = gbv[rg];
            u32x2 wa, wb;
            wa.x = cvt_pk_bf16(o0[4 * rg + 0] * rs * ga.x, o0[4 * rg + 1] * rs * ga.y); wa.y = cvt_pk_bf16(o0[4 * rg + 2] * rs * ga.z, o0[4 * rg + 3] * rs * ga.w);
            wb.x = cvt_pk_bf16(o1[4 * rg + 0] * rs * gb.x, o1[4 * rg + 1] * rs * gb.y); wb.y = cvt_pk_bf16(o1[4 * rg + 2] * rs * gb.z, o1[4 * rg + 3] * rs * gb.w);
            *(u32x2*)(op + d0) = wa; *(u32x2*)(op + 32 + d0) = wb;
        }
    }
    __syncthreads();
}


#define XB_TMO      128
#define XB_XCNT(j)  (256  + 64 * (j))
#define XB_XSUB(j)  (1280 + 64 * (j))
#define XB_XGEN(j)  (2304 + 64 * (j))
#define XB_TOP      3328
#define XB_TOPGEN   3392
#define XCD_BAR_WORDS 3456
#define XB_SPIN_CAP (1u << 18)
__device__ __forceinline__ unsigned xb_ld(unsigned* p)              { return __hip_atomic_load(p, __ATOMIC_RELAXED, __HIP_MEMORY_SCOPE_AGENT); }
__device__ __forceinline__ unsigned xb_add(unsigned* p, unsigned v) { return __hip_atomic_fetch_add(p, v, __ATOMIC_RELAXED, __HIP_MEMORY_SCOPE_AGENT); }
__device__ __forceinline__ unsigned xb_xcc_id() { return (unsigned)__builtin_amdgcn_s_getreg((3 << 11) | 20) & 0xFu; }
#define XB_SPIN(cond, bar) do { unsigned _sp = 0; while (cond) { __builtin_amdgcn_s_sleep(1); \
    if ((++_sp & 255u) == 0u) { if (xb_ld(&(bar)[XB_TMO])) break; if (_sp > XB_SPIN_CAP) { atomicAdd(&(bar)[XB_TMO], 1u); break; } } } } while (0)
struct XcdBarrier { unsigned* bar; unsigned x; volatile LAS unsigned* st; };
__device__ __forceinline__ XcdBarrier xcd_barrier_post(unsigned* bar, volatile LAS unsigned* st) {
    XcdBarrier b; b.bar = bar; b.x = xb_xcc_id(); b.st = st;
    if (threadIdx.x == 0) (void)xb_add(&bar[XB_XCNT(b.x)], 1u);
    return b;
}
__device__ __forceinline__ void xcd_barrier_complete(unsigned* bar, unsigned x, unsigned& nloc, unsigned& nx) {
    const unsigned G = gridDim.x * gridDim.y * gridDim.z;
    unsigned sum, cnt, mine, sp = 0u;
    for (;;) {
        sum = 0u; cnt = 0u; mine = 0u;
#pragma unroll
        for (unsigned j = 0; j < 16; ++j) { const unsigned c = xb_ld(&bar[XB_XCNT(j)]); sum += c; cnt += (c > 0u) ? 1u : 0u; mine = (j == x) ? c : mine; }
        if (sum == G) break;
        __builtin_amdgcn_s_sleep(1);
        if ((++sp & 255u) == 0u) { if (xb_ld(&bar[XB_TMO])) break; if (sp > XB_SPIN_CAP) { atomicAdd(&bar[XB_TMO], 1u); break; } }
    }
    nloc = mine > 0u ? mine : 1u; nx = cnt > 0u ? cnt : 1u;
}
__device__ __forceinline__ void xcd_barrier(const XcdBarrier& b, int wid0) {
    asm volatile("s_waitcnt vmcnt(0)" ::: "memory");
    __syncthreads();
    if (wid0 == 0 && lane_id() == 0) {
        unsigned* bar = b.bar;
        __builtin_amdgcn_s_waitcnt(0);
        unsigned nloc = b.st[0], nx = b.st[1];
        if (nloc == 0u) { xcd_barrier_complete(bar, b.x, nloc, nx); b.st[0] = nloc; b.st[1] = nx; }
        const unsigned old = xb_add(&bar[XB_XSUB(b.x)], 1u);
        const unsigned gen = old / nloc;
        if (old + 1u == (gen + 1u) * nloc) {
            __builtin_amdgcn_fence(__ATOMIC_RELEASE, "agent");
            asm volatile("s_waitcnt vmcnt(0)" ::: "memory");
            const unsigned og = xb_add(&bar[XB_TOP], 1u);
            const unsigned tg = og / nx;
            if (og + 1u == (tg + 1u) * nx) xb_add(&bar[XB_TOPGEN], 1u);
            else XB_SPIN(xb_ld(&bar[XB_TOPGEN]) == tg, bar);
            __builtin_amdgcn_fence(__ATOMIC_ACQUIRE, "agent");
            xb_add(&bar[XB_XGEN(b.x)], 1u);
            asm volatile("s_waitcnt vmcnt(0)" ::: "memory");
        } else {
            XB_SPIN(xb_ld(&bar[XB_XGEN(b.x)]) == gen, bar);
            __builtin_amdgcn_fence(__ATOMIC_ACQUIRE, "agent");
            asm volatile("s_waitcnt vmcnt(0)" ::: "memory");
        }
    }
    __syncthreads();
}

#define IN(k) ld_ptr(ptab, (k))
__device__ __forceinline__ TItem decode_item(int slot, int idx, int total, volatile LAS unsigned long long* ptab, bf16_t* Wb) {
    TItem t; t.valid = idx < total; t.W = nullptr; t.WT = nullptr; t.gk = nullptr; t.K = 0; t.N = 0; t.drow0 = 0; t.k0 = 0; t.n0 = 0;
    if (!t.valid) return t;
    int l, r;
    if (slot == 0) { if (idx < 2112) { l = 0; r = idx; } else if (idx < 3968) { l = 0; r = idx + 2112; } else { l = 1; r = idx - 3968 + 5312; } }
    else if (slot == 1) { l = 0; r = idx + 2112; }
    else if (slot == 2) { l = 1; r = (idx < 2112) ? idx : idx + 2112; }
    else if (slot == 3) { l = 1; r = idx + 5824; }
    else { l = 1; r = idx + 2112; }
    bf16_t* Wl = Wb + (size_t)l * LW;
    const float* src; int K, N; bf16_t* dst; int kind; int gi = -1;
    if (r < 704) { src = IN(4) + (size_t)l * DM * FF; K = DM; N = FF; dst = Wl + OW_GU1; kind = 1; gi = 3; }
    else if (r < 1408) { r -= 704; src = IN(5) + (size_t)l * DM * FF; K = DM; N = FF; dst = Wl + OW_GU1; kind = 2; gi = 3; }
    else if (r < 2112) { r -= 1408; src = IN(6) + (size_t)l * DM * FF; K = FF; N = DM; dst = Wl + OW_D1; kind = 0; }
    else if (r < 2816) { r -= 2112; src = IN(32) + (size_t)l * DM * FF; K = DM; N = FF; dst = Wl + OW_GU2; kind = 1; gi = 31; }
    else if (r < 3520) { r -= 2816; src = IN(33) + (size_t)l * DM * FF; K = DM; N = FF; dst = Wl + OW_GU2; kind = 2; gi = 31; }
    else if (r < 4224) { r -= 3520; src = IN(34) + (size_t)l * DM * FF; K = FF; N = DM; dst = Wl + OW_D2; kind = 0; }
    else if (r < 4800) { r -= 4224; src = IN(9) + (size_t)l * DM * 2304; K = DM; N = 2304; dst = Wl + OW_IN; kind = 3; gi = 8; }
    else if (r < 5056) { r -= 4800; src = IN(22) + (size_t)l * DM * DM; K = DM; N = DM; dst = Wl + OW_O; kind = 0; }
    else if (r < 5312) { r -= 5056; src = IN(26) + (size_t)l * DM * DM; K = DM; N = DM; dst = Wl + OW_Q; kind = 0; gi = 24; }
    else if (r < 5568) { r -= 5312; src = IN(27) + (size_t)l * DM * DM; K = DM; N = DM; dst = Wl + OW_K; kind = 0; }
    else if (r < 5824) { r -= 5568; src = IN(28) + (size_t)l * DM * DM; K = DM; N = DM; dst = Wl + OW_V; kind = 0; }
    else { r -= 5824; src = IN(29) + (size_t)l * DM * DM; K = DM; N = DM; dst = Wl + OW_XO; kind = 0; }
    const int nblk = N / 64, kb = r / nblk, nb = r % nblk, n0 = 64 * nb;
    int drow0 = n0;
    if (kind == 1) drow0 = (n0 >> 7) * 256 + (n0 & 127);
    else if (kind == 2) drow0 = (n0 >> 7) * 256 + 128 + (n0 & 127);
    else if (kind == 3) { if (n0 >= 1792) drow0 = n0 - 256; else if (n0 >= 1536) drow0 = n0 + 512; }
    if (gi >= 0) t.gk = IN(gi) + l * DM;
    t.W = src; t.WT = dst; t.K = K; t.N = N; t.drow0 = drow0; t.k0 = 64 * kb; t.n0 = n0;
    return t;
}
__device__ __forceinline__ void convert_slot(int slot, int part, int nparts, volatile LAS unsigned long long* ptab, bf16_t* Wb, LAS unsigned char* lds, int wid) {
    const int total = (slot == 0) ? 4480 : (slot == 1) ? 2112 : (slot == 2) ? 3200 : (slot == 3) ? 256 : 2112;
    LAS float* scr = (LAS float*)(lds + wid * 16640);
    int lane = lane_id(); asm volatile("" : "+v"(lane));
    for (int idx0 = part; idx0 < total; idx0 += 2 * nparts) {
        TItem ta, tb; f32x4 va[16], vb[16];
        ta = decode_item(slot, idx0, total, ptab, Wb); tb = decode_item(slot, idx0 + nparts, total, ptab, Wb);
        ti_load(ta, va, lane); ti_load(tb, vb, lane);
        ti_finish(ta, va, scr, lane); ti_finish(tb, vb, scr, lane);
    }
}
#undef IN

__global__ void __launch_bounds__(512, 2) mega_fwd(Params p) {
    extern __shared__ __attribute__((aligned(16))) unsigned char lds_raw[];
    LAS unsigned char* lds = (LAS unsigned char*)lds_raw;
    cg::grid_group grid = cg::this_grid();
    const int wid = __builtin_amdgcn_readfirstlane((int)(threadIdx.x >> 6));
    const int tid = wid * 64 + lane_id();
    const int G = gridDim.x, bx = blockIdx.x;
    const int gw = bx * 8 + wid, NGW = G * 8;
    unsigned char* ws = p.ws;
    bf16_t* Wb = (bf16_t*)(ws + WS_W);
    bf16_t* XN = (bf16_t*)(ws + WS_XN);
    bf16_t* BIG = (bf16_t*)(ws + WS_BIG);
    bf16_t* Yb = (bf16_t*)(ws + WS_Y);
    bf16_t* KV = (bf16_t*)(ws + WS_KV);
    float* RSTD = (float*)(ws + WS_CTL + 131072 + 524288);
    float* SLOTS = (float*)(ws + WS_CTL + 131072);
    unsigned* PCNT = (unsigned*)(ws + WS_CTL + 16384);
    unsigned xk = 0;
#define GSYNC() xcd_barrier(bar, wid)
#define LSYNC() do { asm volatile("s_waitcnt vmcnt(0)" ::: "memory"); __builtin_amdgcn_fence(__ATOMIC_RELEASE, "workgroup"); __syncthreads(); __builtin_amdgcn_fence(__ATOMIC_ACQUIRE, "workgroup"); } while (0)
    volatile LAS unsigned long long* ptab = (volatile LAS unsigned long long*)(lds + 146432 + 128);
    volatile LAS unsigned* bst = (volatile LAS unsigned*)(lds + 146432);
    if (tid == 0) { bst[0] = 0u; bst[1] = 0u; }
    __syncthreads();
    XcdBarrier bar = xcd_barrier_post((unsigned*)(ws + WS_CTL), bst);
    if (tid == 0) {
#pragma unroll
        for (int i = 0; i < 36; ++i) ptab[i] = (unsigned long long)p.in[i];
    }
    __syncthreads();
#define IN(k) ld_ptr(ptab, (k))

    {
        convert_slot(0, gw, NGW, ptab, Wb, lds, wid);
        rowpass0(IN(0), XN, RSTD, gw, NGW, lane_id());
        rowpass<false, true>(IN(1), nullptr, nullptr, nullptr, 0.f, Yb, IN(25), 512, gw, NGW, lane_id());
        rowpass<false, true>(IN(1), nullptr, nullptr, nullptr, 0.f, Yb + 512 * DM, IN(25) + DM, 512, gw, NGW, lane_id());
    }
    grid.sync();

#pragma unroll 1
    for (int l = 0; l < 2; ++l) {
        const bf16_t* Wl = Wb + (size_t)l * LW;
        const bf16_t* KX = KV + (size_t)l * 1048576; const bf16_t* VXT = KX + 524288;
#pragma unroll 1
        for (int ff = 0; ff < 2; ++ff) {
            if (ff == 1) {
                {
                    pg8::Gemm g = pg8::make_gemm(XN, Wl + OW_IN, NTOK, ZLD, DM, DM, DM);
                    pg8::StaticOrder S; S.init(NTOK, ZLD, G, bx);
                    pg8::EpiWin E{BIG, ZLD, (const int*)IN(2), 0.25503486f, RSTD, BIG + (size_t)NTOK * ZLD + (size_t)256 * NTOK};
                    pg8::gemm_phase<pg8::EpiWin, pg8::StaticOrder, true, true>(lds, g, S, E, wid);
                }
                {
                    pg8::Gemm g = pg8::make_gemm(Wl + OW_IN + (size_t)2048 * DM, XN, 256, NTOK, DM, DM, DM);
                    pg8::StaticOrder S; S.init(256, NTOK, G, bx);
                    pg8::EpiOutCS E{BIG + (size_t)NTOK * ZLD, NTOK, 1.0f, nullptr, RSTD};
                    pg8::gemm_phase<pg8::EpiOutCS, pg8::StaticOrder, true, true>(lds, g, S, E, wid);
                    if (l == 0) {
#pragma unroll 1
                        for (int i = 0; i < 4; ++i) {
                            const int lk = i >> 1, isv = i & 1;
                            const bf16_t* MN = Yb + (size_t)lk * 512 * DM; const bf16_t* Wk = Wb + (size_t)lk * LW;
                            pg8::Gemm gk = isv ? pg8::make_gemm(Wk + OW_V, MN, DM, 512, DM, DM, DM) : pg8::make_gemm(MN, Wk + OW_K, 512, DM, DM, DM, DM);
                            pg8::StaticOrder Sk; Sk.init(gk.M, gk.N, G, (bx + 2 * G - 64 - 8 * i) % G);
                            pg8::EpiOut Ek{KV + (size_t)lk * 1048576 + (isv ? 524288 : 0), isv ? 512 : DM, 1.0f, nullptr, nullptr};
                            pg8::gemm_phase<pg8::EpiOut, pg8::StaticOrder, true, true>(lds, gk, Sk, Ek, wid);
                        }
                        if (bx >= 96) convert_slot(2, (bx - 96) * 8 + wid, 160 * 8, ptab, Wb, lds, wid);
                    }
                }
                GSYNC();
                {
                    bf16_t* YC = Yb; const bf16_t* Z = BIG; const bf16_t* VT = BIG + (size_t)NTOK * ZLD;
#ifdef PROBE_LM2
                    for (int rep = 0; rep < 2; ++rep)
#endif
                    for (int tl = bx; tl < 256; tl += G)
                        light_mixers_tile(lds, Z, YC, tl, IN(10) + (size_t)l * 16384, IN(11) + l * 256, IN(12) + l * 768, IN(18) + l * 31 * 256, IN(19) + l * 256, IN(20) + l * 256, IN(21) + l * 256, wid);
                    float d1 = 0.f, d2 = 0.f;
                    int lane_l = lane_id(); asm volatile("" : "+v"(lane_l));
                    if (lane_l < 32) { d1 = IN(13)[l * 32 + lane_l] * IN(14)[l * 32 + lane_l]; d2 = IN(15)[l * 32 + lane_l] * IN(16)[l * 32 + lane_l]; }
                    d1 = wave_sum(d1); d2 = wave_sum(d2);
                    const float lam_init = __uint_as_float((unsigned)__builtin_amdgcn_readfirstlane((l == 0) ? (int)0x3e4ccccd : (int)0x3eb60549));
                    const float lam = __uint_as_float((unsigned)__builtin_amdgcn_readfirstlane((int)__float_as_uint(expf(d1) - expf(d2) + lam_init)));
                    const float osc = __uint_as_float((unsigned)__builtin_amdgcn_readfirstlane((int)__float_as_uint(1.0f - lam_init)));
#ifdef PROBE_ATT2
                    for (int rep = 0; rep < 2; ++rep)
#endif
                    for (int pr = bx; pr < 256; pr += G) {
                        const int bh = pr & 7, s = pr >> 3;
                        dattn_unit(lds, VT + (size_t)256 * NTOK, VT, YC, bh >> 2, bh & 3, s, lam, lam_init, IN(17) + l * 64, wid);
                        dattn_unit(lds, VT + (size_t)256 * NTOK, VT, YC, bh >> 2, bh & 3, 63 - s, lam, lam_init, IN(17) + l * 64, wid);
                    }
                }
                GSYNC();
                {
                    pg8::Gemm g = pg8::make_gemm(Yb, Wl + OW_O, NTOK, DM, DM, DM, DM);
                    pg8::StaticOrder S; S.init(NTOK, DM, G, bx);
                    pg8::EpiRes<false> E{XN, IN(23) + l * DM, 1.0f, RSTD, nullptr, SLOTS, PCNT, xk};
                    pg8::gemm_phase<pg8::EpiRes<false>, pg8::StaticOrder, false, true>(lds, g, S, E, wid);
                    xk += 1;
                }
                GSYNC();
                {
                    pg8::Gemm g = pg8::make_gemm(XN, Wl + OW_Q, NTOK, DM, DM, DM, DM);
                    pg8::StaticOrder S; S.init(NTOK, DM, G, bx);
                    pg8::EpiOut E{BIG, DM, 0.09016844005556021f, RSTD, nullptr};
                    pg8::gemm_phase<pg8::EpiOut, pg8::StaticOrder, true, true>(lds, g, S, E, wid);
                }
                LSYNC();
                {
                    pg8::Gemm g = pg8::make_gemm(BIG, KX, NTOK, DM, 256, DM, DM);
                    g.a_pn = 256; g.b_pn = 256; g.b_pb = (long)256 * DM; g.bshift = 5;
                    pg8::StaticOrder S; S.init(NTOK, DM, G, bx);
                    pg8::EpiSoftmax E{BIG + (size_t)NTOK * DM, DM};
                    pg8::gemm_phase<pg8::EpiSoftmax, pg8::StaticOrder, false, true>(lds, g, S, E, wid);
                }
                LSYNC();
                {
                    pg8::Gemm g = pg8::make_gemm(BIG + (size_t)NTOK * DM, VXT, NTOK, DM, 256, DM, 512);
                    g.a_pn = 256; g.b_pn = (long)256 * 512; g.b_pb = 256; g.bshift = 5;
                    pg8::StaticOrder S; S.init(NTOK, DM, G, bx);
                    pg8::EpiOut E{BIG, DM, 1.0f, nullptr, nullptr};
                    pg8::gemm_phase<pg8::EpiOut, pg8::StaticOrder, true, true>(lds, g, S, E, wid);
                }
                GSYNC();
                {
                    pg8::Gemm g = pg8::make_gemm(BIG, Wl + OW_XO, NTOK, DM, DM, DM, DM);
                    pg8::StaticOrder S; S.init(NTOK, DM, G, bx);
                    pg8::EpiRes<false> E{XN, IN(30) + l * DM, 1.0f, RSTD, nullptr, SLOTS, PCNT, xk};
                    pg8::gemm_phase<pg8::EpiRes<false>, pg8::StaticOrder, false, true>(lds, g, S, E, wid);
                    xk += 1;
                }
                GSYNC();
            }
            {
                pg8::Gemm g = pg8::make_gemm(XN, Wl + (ff ? OW_GU2 : OW_GU1), NTOK, 2 * FF, DM, DM, DM);
                pg8::StaticOrder S; S.init(NTOK, 2 * FF, G, bx);
                pg8::EpiSwiGLU E{BIG, FF, RSTD};
                pg8::gemm_phase<pg8::EpiSwiGLU, pg8::StaticOrder, true, true>(lds, g, S, E, wid);
                if (bx >= 128 && !(l == 1 && ff == 1)) {
                    const int slot = (l == 0) ? (ff == 0 ? 1 : 3) : 4;
                    convert_slot(slot, (bx - 128) * 8 + wid, 128 * 8, ptab, Wb, lds, wid);
                }
            }
            GSYNC();
            {
                pg8::Gemm g = pg8::make_gemm(BIG, Wl + (ff ? OW_D2 : OW_D1), NTOK, DM, FF, FF, FF);
                pg8::StaticOrder S; S.init(NTOK, DM, G, bx);
                if (ff == 1 && l == 1) {
                    pg8::EpiRes<true> E{XN, IN(35) + l * DM, 0.5f, RSTD, p.out, SLOTS, PCNT, xk};
                    pg8::gemm_phase<pg8::EpiRes<true>, pg8::StaticOrder, false, true>(lds, g, S, E, wid);
                } else {
                    pg8::EpiRes<false> E{XN, IN(ff ? 35 : 7) + l * DM, 0.5f, RSTD, nullptr, SLOTS, PCNT, xk};
                    pg8::gemm_phase<pg8::EpiRes<false>, pg8::StaticOrder, false, true>(lds, g, S, E, wid);
                    xk += 1;
                }
            }
            if (!(ff == 1 && l == 1)) GSYNC();
        }
    }
}

extern "C" void kernel_launch(void* const* d_in, const int* in_sizes, int n_in, void* d_out, int out_size, void* d_ws, size_t ws_size, hipStream_t stream) {
    static int grid = 0;
    if (grid == 0) {
        if (n_in != 36 || out_size != NTOK * DM || ws_size < WS_END) { fprintf(stderr, "kernel_launch: unexpected problem (n_in %d out %d ws %zu)\n", n_in, out_size, ws_size); grid = -1; return; }
        int dev = 0, cus = 0, per_cu = 0;
        hipGetDevice(&dev);
        hipDeviceGetAttribute(&cus, hipDeviceAttributeMultiprocessorCount, dev);
        if (hipFuncSetAttribute((const void*)mega_fwd, hipFuncAttributeMaxDynamicSharedMemorySize, LDS_BYTES) != hipSuccess) { fprintf(stderr, "kernel_launch: hipFuncSetAttribute failed\n"); grid = -1; return; }
        hipOccupancyMaxActiveBlocksPerMultiprocessor(&per_cu, (const void*)mega_fwd, 512, LDS_BYTES);
        if (per_cu < 1) { fprintf(stderr, "kernel_launch: occupancy query says %d\n", per_cu); per_cu = 1; }
        (void)hipGetLastError();
        grid = cus;
        if (grid != 256) { fprintf(stderr, "kernel_launch: %d CUs (this kernel needs 256)\n", grid); grid = -1; return; }
    }
    if (grid < 0) return;
    if (hipMemsetAsync((char*)d_ws + WS_CTL, 0, 65536, stream) != hipSuccess) { fprintf(stderr, "kernel_launch: memset failed\n"); return; }
    Params p{};
    for (int i = 0; i < 36; ++i) p.in[i] = (const float*)d_in[i];
    p.out = (float*)d_out; p.ws = (unsigned char*)d_ws;
    void* args[] = {&p};
    hipError_t e = hipLaunchCooperativeKernel((const void*)mega_fwd, dim3(grid), dim3(512), args, LDS_BYTES, stream);
    if (e != hipSuccess) fprintf(stderr, "cooperative launch failed: %s (grid %d)\n", hipGetErrorString(e), grid);
}
```

```cpp
#include <hip/hip_runtime.h>
#include <hip/hip_cooperative_groups.h>
#include <cstdio>
#include <cstdint>
#include <cmath>
namespace cg = cooperative_groups;

#define LAS __attribute__((address_space(3)))
typedef unsigned short bf16_t;
typedef short bf16x8 __attribute__((ext_vector_type(8)));
typedef float f32x4 __attribute__((ext_vector_type(4)));
typedef float f32x16 __attribute__((ext_vector_type(16)));
typedef unsigned u32x4 __attribute__((ext_vector_type(4)));
typedef unsigned u32x2 __attribute__((ext_vector_type(2)));

#ifndef USE_CG_SYNC
#define USE_CG_SYNC 1
#endif

constexpr int NTOK = 16384, DM = 1024, FF = 2816, SEQ = 8192, ZLD = 2048;
constexpr float EPS = 1e-6f;
constexpr size_t LW = 24903680;
constexpr size_t OW_GU1 = 0, OW_D1 = 5767168, OW_GU2 = 8650752, OW_D2 = 14417920, OW_IN = 17301504, OW_O = 19660800,
                 OW_Q = 20709376, OW_K = 21757952, OW_V = 22806528, OW_XO = 23855104;
constexpr size_t WS_W = 0, WS_XN = 99614720, WS_BIG = 133169152, WS_Y = 225443840, WS_KV = 258998272, WS_CTL = 263192576, WS_END = 263192576 + 131072 + 524288 + 262144;
constexpr int LDS_BYTES = 147456;
constexpr int ITEMS_PER_LAYER = 6080;

struct Params {
    const float* in[36];
    float* out;
    unsigned char* ws;
};

__device__ __forceinline__ unsigned cvt_pk_bf16(float lo, float hi) { unsigned r; asm volatile("v_cvt_pk_bf16_f32 %0, %1, %2" : "=v"(r) : "v"(lo), "v"(hi)); return r; }
typedef float f32x2_t __attribute__((ext_vector_type(2))); typedef __bf16 bf16x2_t __attribute__((ext_vector_type(2)));
__device__ __forceinline__ unsigned cvtpk_s(float lo, float hi) { f32x2_t v = {lo, hi}; bf16x2_t b = __builtin_convertvector(v, bf16x2_t); return __builtin_bit_cast(unsigned, b); }
__device__ __forceinline__ int lane_id() { int l; asm volatile("v_mbcnt_lo_u32_b32 %0, -1, 0\n\tv_mbcnt_hi_u32_b32 %0, -1, %0" : "=v"(l)); return l; }
__device__ __forceinline__ float bf_lo(unsigned w) { return __uint_as_float(w << 16); }
__device__ __forceinline__ float bf_hi(unsigned w) { return __uint_as_float(w & 0xffff0000u); }
__device__ __forceinline__ float bf2f(bf16_t h) { return __uint_as_float(((unsigned)h) << 16); }
template <int M> __device__ __forceinline__ float shx(float v) {
    static_assert(M < 32, "use sum32 / max32 for the half-wave exchange");
    return __uint_as_float((unsigned)__builtin_amdgcn_ds_swizzle((int)__float_as_uint(v), (M << 10) | 0x1f));
}
__device__ __forceinline__ float sum32(float v) { auto rr = __builtin_amdgcn_permlane32_swap(__float_as_uint(v), __float_as_uint(v), false, false); return __uint_as_float(rr[0]) + __uint_as_float(rr[1]); }
__device__ __forceinline__ float max32(float v) { auto rr = __builtin_amdgcn_permlane32_swap(__float_as_uint(v), __float_as_uint(v), false, false); return fmaxf(__uint_as_float(rr[0]), __uint_as_float(rr[1])); }
__device__ __forceinline__ float wave_sum(float v) {
    v += shx<1>(v); v += shx<2>(v); v += shx<4>(v); v += shx<8>(v); v += shx<16>(v);
    { auto rr = __builtin_amdgcn_permlane32_swap(__float_as_uint(v), __float_as_uint(v), false, false); v = __uint_as_float(rr[0]) + __uint_as_float(rr[1]); }
    return v;
}
__device__ __forceinline__ float fast_exp2(float x) { return __builtin_amdgcn_exp2f(x); }
__device__ __forceinline__ float fast_rcp(float x) { return __builtin_amdgcn_rcpf(x); }
__device__ __forceinline__ float sigmoidf_(float x) { return fast_rcp(1.0f + fast_exp2(-1.4426950408889634f * x)); }
__device__ __forceinline__ void ld8(const bf16_t* p, float (&f)[8]) {
    const u32x4 w = *(const u32x4*)p;
    f[0] = bf_lo(w.x); f[1] = bf_hi(w.x); f[2] = bf_lo(w.y); f[3] = bf_hi(w.y); f[4] = bf_lo(w.z); f[5] = bf_hi(w.z); f[6] = bf_lo(w.w); f[7] = bf_hi(w.w);
}

__device__ __forceinline__ const float* ld_ptr(volatile LAS unsigned long long* tab, int k) {
    const unsigned long long v = tab[k];
    const unsigned lo = __builtin_amdgcn_readfirstlane((unsigned)v), hi = __builtin_amdgcn_readfirstlane((unsigned)(v >> 32));
    return (const float*)(((unsigned long long)hi << 32) | lo);
}

namespace pg8 {
constexpr int BM = 256, BK = 64, HALF = 128, HTB = HALF * BK * 2, STAGE_BYTES = 8 * HTB, NXCD = 8, WGM = 8;
__host__ __device__ __forceinline__ int lds_byte(int r, int c) { const int st = (r >> 4) * 2 + (c >> 5), rr = r & 15, cc = c & 31, ob = rr * 64 + cc * 2; return st * 1024 + (ob ^ (((ob >> 9) & 1) << 5)); }
__host__ __device__ __forceinline__ void stage_rc(int b, int& R, int& C) { const int st = b / 1024, sb = b % 1024, swz = sb ^ (((sb >> 9) & 1) << 5); R = (st >> 1) * 16 + swz / 64; C = (st & 1) * 32 + (swz % 64) / 2; }
__host__ __device__ __forceinline__ int perm32(int rho) { const int n = rho >> 4, i = rho & 15; return 8 * (i >> 2) + 4 * n + (i & 3); }

struct Unit { int pm, pn; };
struct Gemm { const bf16_t* A; const bf16_t* Bt; int M, N, K, lda, ldb; long a_pm, a_pn, b_pn, b_pb; int bshift; };
__device__ __forceinline__ Gemm make_gemm(const bf16_t* A, const bf16_t* Bt, int M, int N, int K, int lda, int ldb) {
    Gemm g; g.A = A; g.Bt = Bt; g.M = M; g.N = N; g.K = K; g.lda = lda; g.ldb = ldb; g.a_pm = (long)BM * lda; g.a_pn = 0; g.b_pn = (long)BM * ldb; g.b_pb = 0; g.bshift = 0; return g;
}

struct StaticOrder {
    int nM, nN, nwg, G, c;
    __device__ void init(int M, int N, int G_, int c_) { nM = M / BM; nN = N / BM; nwg = nM * nN; G = G_; c = c_; }
    __device__ bool next(int i, Unit& u) const {
        const long L = (long)i * G + c; if (L >= nwg) return false;
        int wgid = (int)L; { const int q = nwg / NXCD, r = nwg % NXCD, xcd = wgid % NXCD, off = wgid / NXCD; wgid = (xcd < r ? xcd * (q + 1) : r * (q + 1) + (xcd - r) * q) + off; }
        const int nig = WGM * nN, gid = wgid / nig, fm = gid * WGM, gsz = (nM - fm) < WGM ? (nM - fm) : WGM;
        u.pm = fm + ((wgid % nig) % gsz); u.pn = (wgid % nig) / gsz; return true;
    }
};

__device__ __forceinline__ float rstd_of(const float* pss, int row) { const f32x4 p = *(const f32x4*)(pss + 4 * (size_t)row); return __builtin_amdgcn_rsqf(((p.x + p.y) + (p.z + p.w)) * (1.0f / 1024.0f) + EPS); }
__device__ __forceinline__ float pss_lane(const float* pss, int row, int fq) { return pss[4 * (size_t)row + fq]; }
__device__ __forceinline__ float rstd_fin(float v) { v += shx<16>(v); v = sum32(v); return __builtin_amdgcn_rsqf(v * (1.0f / 1024.0f) + EPS); }
template <int K> __device__ __forceinline__ float bcast16(float v) {
    return __uint_as_float((unsigned)__builtin_amdgcn_ds_swizzle((int)__float_as_uint(v), 0x10 | (K << 5)));
}
template <bool HAS_CS> struct EpiOutT {
    static constexpr bool PERM = true, AFTER_DRAIN = false;
    bf16_t* O; int ldc; float sc; const float* rs; const float* cs;
    __device__ __forceinline__ void operator()(const f32x4 (&acc)[2][2][4][2], const Unit& u, int wr, int wc, int fr, int fq) const {
        const int row0 = u.pm * BM + wr * 64 + fr; const int col0 = u.pn * BM + wc * 32 + 8 * fq;
        f32x4 cv[2][2];
        if constexpr (HAS_CS) {
            const float r = rstd_of(cs, col0 + (fr >> 3) * HALF + (fr & 7));
            cv[0][0] = (f32x4){bcast16<0>(r), bcast16<1>(r), bcast16<2>(r), bcast16<3>(r)};   cv[0][1] = (f32x4){bcast16<4>(r), bcast16<5>(r), bcast16<6>(r), bcast16<7>(r)};
            cv[1][0] = (f32x4){bcast16<8>(r), bcast16<9>(r), bcast16<10>(r), bcast16<11>(r)}; cv[1][1] = (f32x4){bcast16<12>(r), bcast16<13>(r), bcast16<14>(r), bcast16<15>(r)};
        } else {
#pragma unroll
            for (int bj = 0; bj < 2; ++bj)
#pragma unroll
                for (int n = 0; n < 2; ++n) cv[bj][n] = (f32x4){1.f, 1.f, 1.f, 1.f};
        }
        float rsv[2][4];
#pragma unroll
        for (int ai = 0; ai < 2; ++ai)
#pragma unroll
            for (int m = 0; m < 4; ++m) rsv[ai][m] = rs ? pss_lane(rs, row0 + ai * HALF + m * 16, fq) : 0.f;
        if (rs) {
#pragma unroll
            for (int ai = 0; ai < 2; ++ai)
#pragma unroll
                for (int m = 0; m < 4; ++m) rsv[ai][m] = rstd_fin(rsv[ai][m]);
        } else {
#pragma unroll
            for (int ai = 0; ai < 2; ++ai)
#pragma unroll
                for (int m = 0; m < 4; ++m) rsv[ai][m] = 1.0f;
        }
#pragma unroll
        for (int ai = 0; ai < 2; ++ai)
#pragma unroll
            for (int m = 0; m < 4; ++m) { bf16_t* rowp = O + (size_t)(row0 + ai * HALF + m * 16) * ldc + col0;
                const float rsc = rsv[ai][m];
#pragma unroll
                for (int bj = 0; bj < 2; ++bj) { f32x4 v0, v1;
                    if constexpr (HAS_CS) { v0 = acc[ai][bj][m][0] * cv[bj][0] * rsc; v1 = acc[ai][bj][m][1] * cv[bj][1] * rsc; }
                    else { const float s_ = sc * rsc; v0 = acc[ai][bj][m][0] * s_; v1 = acc[ai][bj][m][1] * s_; }
                    u32x4 w; w.x = cvt_pk_bf16(v0[0], v0[1]); w.y = cvt_pk_bf16(v0[2], v0[3]); w.z = cvt_pk_bf16(v1[0], v1[1]); w.w = cvt_pk_bf16(v1[2], v1[3]);
                    *(u32x4*)(rowp + bj * HALF) = w; } }
    }
};
typedef EpiOutT<false> EpiOut; typedef EpiOutT<true> EpiOutCS;
struct EpiSwiGLU {
    static constexpr bool PERM = true, AFTER_DRAIN = false;
    bf16_t* O; int ldc; const float* rs;
    __device__ __forceinline__ void operator()(const f32x4 (&acc)[2][2][4][2], const Unit& u, int wr, int wc, int fr, int fq) const {
        const int row0 = u.pm * BM + wr * 64 + fr; const int col0 = u.pn * HALF + wc * 32 + 8 * fq;
        float rsv[2][4];
#pragma unroll
        for (int ai = 0; ai < 2; ++ai)
#pragma unroll
            for (int m = 0; m < 4; ++m) rsv[ai][m] = pss_lane(rs, row0 + ai * HALF + m * 16, fq);
#pragma unroll
        for (int ai = 0; ai < 2; ++ai)
#pragma unroll
            for (int m = 0; m < 4; ++m) rsv[ai][m] = rstd_fin(rsv[ai][m]);
#pragma unroll
        for (int ai = 0; ai < 2; ++ai)
#pragma unroll
            for (int m = 0; m < 4; ++m) { bf16_t* rowp = O + (size_t)(row0 + ai * HALF + m * 16) * ldc + col0;
                const float rsc = rsv[ai][m];
                float h[8], gg[8], uu[8], ee[8];
#pragma unroll
                for (int q = 0; q < 8; ++q) { gg[q] = acc[ai][0][m][q >> 2][q & 3] * rsc; uu[q] = acc[ai][1][m][q >> 2][q & 3] * rsc; }
#pragma unroll
                for (int q = 0; q < 8; ++q) ee[q] = fast_exp2(-1.4426950408889634f * gg[q]);
#pragma unroll
                for (int q = 0; q < 8; ++q) uu[q] *= gg[q];
#pragma unroll
                for (int q = 0; q < 8; ++q) ee[q] = fast_rcp(1.0f + ee[q]);
#pragma unroll
                for (int q = 0; q < 8; ++q) h[q] = uu[q] * ee[q];
                u32x4 w; w.x = cvt_pk_bf16(h[0], h[1]); w.y = cvt_pk_bf16(h[2], h[3]); w.z = cvt_pk_bf16(h[4], h[5]); w.w = cvt_pk_bf16(h[6], h[7]);
                *(u32x4*)rowp = w; }
    }
};
struct EpiWin {
    static constexpr bool PERM = true, AFTER_DRAIN = false;
    bf16_t* O; int ldc; const int* pos; float qscale; const float* rs; bf16_t* QC;
    __device__ __forceinline__ void operator()(f32x4 (&acc)[2][2][4][2], const Unit& u, int wr, int wc, int fr, int fq) const {
        const int row0 = u.pm * BM + wr * 64 + fr; const int col0 = u.pn * BM + wc * 32 + 8 * fq;
        const bool rope = (u.pn == 4 || u.pn == 5);
        const float sc = (u.pn == 4) ? qscale : 1.0f;
        float rsv[2][4];
#pragma unroll
        for (int ai = 0; ai < 2; ++ai)
#pragma unroll
            for (int m = 0; m < 4; ++m) rsv[ai][m] = pss_lane(rs, row0 + ai * HALF + m * 16, fq);
#pragma unroll
        for (int ai = 0; ai < 2; ++ai)
#pragma unroll
            for (int m = 0; m < 4; ++m) rsv[ai][m] = sc * rstd_fin(rsv[ai][m]);
        if (rope && fq == 0) {
            int posv[2][4];
#pragma unroll
            for (int ai = 0; ai < 2; ++ai)
#pragma unroll
                for (int m = 0; m < 4; ++m) posv[ai][m] = pos[row0 + ai * HALF + m * 16];
#pragma unroll
            for (int ai = 0; ai < 2; ++ai)
#pragma unroll
                for (int m = 0; m < 4; ++m) {
                    const float p = (float)posv[ai][m];
                    const float invf[4] = {1.0f, 0.03760603093086394f, 0.0014142135623730951f, 5.318295896944989e-05f};
                    float cs[4], sn[4];
#pragma unroll
                    for (int i = 0; i < 4; ++i) { const float ang = p * invf[i];
                        const float fr_ = __builtin_amdgcn_fractf(ang * 0.15915494309189535f);
                        sn[i] = __builtin_amdgcn_sinf(fr_); cs[i] = __builtin_amdgcn_cosf(fr_); }
#pragma unroll
                    for (int bj = 0; bj < 2; ++bj) { const f32x4 x1 = acc[ai][bj][m][0], x2 = acc[ai][bj][m][1];
#pragma unroll
                        for (int i = 0; i < 4; ++i) { acc[ai][bj][m][0][i] = x1[i] * cs[i] - x2[i] * sn[i]; acc[ai][bj][m][1][i] = x2[i] * cs[i] + x1[i] * sn[i]; } }
                }
        }
#pragma unroll
        for (int ai = 0; ai < 2; ++ai)
#pragma unroll
            for (int m = 0; m < 4; ++m) { const int row = row0 + ai * HALF + m * 16; bf16_t* rowp = O + (size_t)row * ldc + col0;
                const float rsc = rsv[ai][m];
                bf16_t* cp = QC + (rope ? (size_t)(u.pn - 4) * 8 * 8192 * 64 : 0) + ((size_t)((row >> 13) * 4 + (wc >> 1)) * 8192 + (row & 8191)) * 64 + (wc & 1) * 32 + 8 * fq;
#pragma unroll
                for (int bj = 0; bj < 2; ++bj) { const f32x4 v0 = acc[ai][bj][m][0] * rsc, v1 = acc[ai][bj][m][1] * rsc;
                    u32x4 w; w.x = cvt_pk_bf16(v0[0], v0[1]); w.y = cvt_pk_bf16(v0[2], v0[3]); w.z = cvt_pk_bf16(v1[0], v1[1]); w.w = cvt_pk_bf16(v1[2], v1[3]);
                    if (rope) *(u32x4*)(cp + (size_t)bj * 2 * 8192 * 64) = w; else *(u32x4*)(rowp + bj * HALF) = w; } }
    }
};
struct EpiSoftmax {
    static constexpr bool PERM = true, AFTER_DRAIN = true;
    bf16_t* O; int ldc;
    __device__ __forceinline__ void fused(f32x4 (&acc)[2][2][4][2], const Unit& u, int wr, int wc, int fr, int fq, LAS unsigned char* lds, int wid, int lane) const {
        LAS float* Pm = (LAS float*)lds; LAS float* Ps = (LAS float*)(lds + 4096);
#pragma unroll
        for (int ai = 0; ai < 2; ++ai)
#pragma unroll
            for (int m = 0; m < 4; ++m) { float v = -INFINITY;
#pragma unroll
                for (int bj = 0; bj < 2; ++bj)
#pragma unroll
                    for (int n = 0; n < 2; ++n) { const f32x4 x = acc[ai][bj][m][n]; v = fmaxf(v, fmaxf(fmaxf(x[0], x[1]), fmaxf(x[2], x[3]))); }
                v = fmaxf(v, shx<16>(v)); v = max32(v);
                if (fq == 0) Pm[(ai * HALF + wr * 64 + m * 16 + fr) * 4 + wc] = v; }
        __syncthreads();
#pragma unroll
        for (int ai = 0; ai < 2; ++ai)
#pragma unroll
            for (int m = 0; m < 4; ++m) { const int row = ai * HALF + wr * 64 + m * 16 + fr; const f32x4 t = *(const LAS f32x4*)(Pm + row * 4);
                const float mx = fmaxf(fmaxf(t[0], t[1]), fmaxf(t[2], t[3])); float s = 0.f;
#pragma unroll
                for (int bj = 0; bj < 2; ++bj)
#pragma unroll
                    for (int n = 0; n < 2; ++n)
#pragma unroll
                        for (int j = 0; j < 4; ++j) acc[ai][bj][m][n][j] = fast_exp2(acc[ai][bj][m][n][j] - mx);
#pragma unroll
                for (int bj = 0; bj < 2; ++bj)
#pragma unroll
                    for (int n = 0; n < 2; ++n) { const f32x4 x = acc[ai][bj][m][n]; s += (x[0] + x[1]) + (x[2] + x[3]); }
                {
                s += shx<16>(s); s = sum32(s);
                if (fq == 0) Ps[row * 4 + wc] = s; } }
        __syncthreads();
        const int col0 = u.pn * BM + wc * 32 + 8 * fq;
#pragma unroll
        for (int ai = 0; ai < 2; ++ai)
#pragma unroll
            for (int m = 0; m < 4; ++m) { const int row = ai * HALF + wr * 64 + m * 16 + fr; const f32x4 t = *(const LAS f32x4*)(Ps + row * 4);
                const float inv = 1.0f / ((t[0] + t[1]) + (t[2] + t[3]));
                bf16_t* rowp = O + (size_t)(u.pm * BM + row) * ldc + col0;
#pragma unroll
                for (int bj = 0; bj < 2; ++bj) { const f32x4 v0 = acc[ai][bj][m][0] * inv, v1 = acc[ai][bj][m][1] * inv;
                    u32x4 w; w.x = cvt_pk_bf16(v0[0], v0[1]); w.y = cvt_pk_bf16(v0[2], v0[3]); w.z = cvt_pk_bf16(v1[0], v1[1]); w.w = cvt_pk_bf16(v1[2], v1[3]);
                    *(u32x4*)(rowp + bj * HALF) = w; } }
        __syncthreads();
    }
};


__device__ __forceinline__ void panel_exchange(const float (&part)[2][4], float* slotbuf, unsigned* cntw, unsigned want, int pm, int pn, int wr, int wc, int fr, int fq, LAS unsigned char* lds, int wid, int lane) {
    LAS float* P = (LAS float*)lds; LAS float* S = (LAS float*)(lds + 8192);
    if (fq == 0) {
#pragma unroll
        for (int ai = 0; ai < 2; ++ai)
#pragma unroll
            for (int m = 0; m < 4; ++m) P[(ai * HALF + wr * 64 + m * 16 + fr) * 4 + wc] = part[ai][m];
    }
    __syncthreads();
    const int tid = wid * 64 + lane;
    if (tid < 256) { const f32x4 t = *(const LAS f32x4*)(P + tid * 4);
        __hip_atomic_store(slotbuf + ((size_t)(pm * BM + tid)) * 4 + pn, (t.x + t.y) + (t.z + t.w), __ATOMIC_RELAXED, __HIP_MEMORY_SCOPE_AGENT); }
    asm volatile("s_waitcnt vmcnt(0)" ::: "memory");
    if (wid < 4 && lane == 0) __hip_atomic_fetch_add(cntw, 1u, __ATOMIC_RELAXED, __HIP_MEMORY_SCOPE_AGENT);
    if (wid == 0) {
        unsigned sp = 0;
        while ((unsigned)__builtin_amdgcn_readfirstlane(__hip_atomic_load(cntw, __ATOMIC_RELAXED, __HIP_MEMORY_SCOPE_AGENT)) < want) { __builtin_amdgcn_s_sleep(2); if (++sp > (1u << 22)) break; }
    }
    asm volatile("s_waitcnt vmcnt(0) lgkmcnt(0)" ::: "memory"); __syncthreads();
    if (tid < 256) { const float* sl = slotbuf + ((size_t)(pm * BM + tid)) * 4;
        f32x4 q; asm volatile("global_load_dwordx4 %0, %1, off sc1\n\ts_waitcnt vmcnt(0)" : "=&v"(q) : "v"(sl) : "memory");
        S[tid] = (q.x + q.y) + (q.z + q.w); }
    __syncthreads();
}
template <bool FINAL> struct EpiRes {
    static constexpr bool PERM = true, AFTER_DRAIN = true;
    bf16_t* XB; const float* gpost; float wgt; float* rstd; float* outf; float* slots; unsigned* cnt; unsigned xk;
    __device__ __forceinline__ void fused(f32x4 (&acc)[2][2][4][2], const Unit& u, int wr, int wc, int fr, int fq, LAS unsigned char* lds, int wid, int lane) const {
        const LAS float* S = (const LAS float*)(lds + 8192);
        const int col0 = u.pn * BM + wc * 32 + 8 * fq;
        u32x4 xres[2][4][2]; f32x4 gv[2][2];
#pragma unroll
        for (int ai = 0; ai < 2; ++ai)
#pragma unroll
            for (int m = 0; m < 4; ++m)
#pragma unroll
                for (int bj = 0; bj < 2; ++bj) xres[ai][m][bj] = *(const u32x4*)(XB + (size_t)(u.pm * BM + ai * HALF + wr * 64 + m * 16 + fr) * 1024 + col0 + bj * HALF);
#pragma unroll
        for (int bj = 0; bj < 2; ++bj)
#pragma unroll
            for (int n = 0; n < 2; ++n) gv[bj][n] = *(const f32x4*)(gpost + col0 + bj * HALF + 4 * n);
        float part[2][4];
#pragma unroll
        for (int ai = 0; ai < 2; ++ai)
#pragma unroll
            for (int m = 0; m < 4; ++m) { float s = 0.f;
#pragma unroll
                for (int bj = 0; bj < 2; ++bj)
#pragma unroll
                    for (int n = 0; n < 2; ++n) { const f32x4 x = acc[ai][bj][m][n]; s += (x[0] * x[0] + x[1] * x[1]) + (x[2] * x[2] + x[3] * x[3]); }
                s += shx<16>(s); s = sum32(s); part[ai][m] = s; }
        panel_exchange(part, slots + (size_t)(xk & 1u) * 65536, cnt + 64 * u.pm, 16u * (xk + 1u), u.pm, u.pn, wr, wc, fr, fq, lds, wid, lane);
#pragma unroll
        for (int ai = 0; ai < 2; ++ai)
#pragma unroll
            for (int m = 0; m < 4; ++m) { const int row = ai * HALF + wr * 64 + m * 16 + fr; const float rs = wgt * __builtin_amdgcn_rsqf(S[row] * (1.0f / 1024.0f) + EPS);
                bf16_t* xp = XB + (size_t)(u.pm * BM + row) * 1024 + col0; float s2 = 0.f;
#pragma unroll
                for (int bj = 0; bj < 2; ++bj) { const u32x4 xw = xres[ai][m][bj];
                    const f32x4 x0 = (f32x4){bf_lo(xw.x), bf_hi(xw.x), bf_lo(xw.y), bf_hi(xw.y)}, x1 = (f32x4){bf_lo(xw.z), bf_hi(xw.z), bf_lo(xw.w), bf_hi(xw.w)};
                    const f32x4 v0 = x0 + acc[ai][bj][m][0] * gv[bj][0] * rs, v1 = x1 + acc[ai][bj][m][1] * gv[bj][1] * rs;
                    if constexpr (FINAL) { float* op = outf + (size_t)(u.pm * BM + row) * 1024 + col0 + bj * HALF; *(f32x4*)op = v0; *(f32x4*)(op + 4) = v1; }
                    else { u32x4 w; w.x = cvt_pk_bf16(v0[0], v0[1]); w.y = cvt_pk_bf16(v0[2], v0[3]); w.z = cvt_pk_bf16(v1[0], v1[1]); w.w = cvt_pk_bf16(v1[2], v1[3]);
                        *(u32x4*)(xp + bj * HALF) = w;
                        const float a0 = bf_lo(w.x), a1 = bf_hi(w.x), a2 = bf_lo(w.y), a3 = bf_hi(w.y), a4 = bf_lo(w.z), a5 = bf_hi(w.z), a6 = bf_lo(w.w), a7 = bf_hi(w.w);
                        s2 += ((a0 * a0 + a1 * a1) + (a2 * a2 + a3 * a3)) + ((a4 * a4 + a5 * a5) + (a6 * a6 + a7 * a7)); } }
                if constexpr (!FINAL) { s2 += shx<16>(s2); s2 = sum32(s2); part[ai][m] = s2; } }
        if constexpr (!FINAL) {
            LAS float* P = (LAS float*)lds;
            if (fq == 0) {
#pragma unroll
                for (int ai = 0; ai < 2; ++ai)
#pragma unroll
                    for (int m = 0; m < 4; ++m) P[(ai * HALF + wr * 64 + m * 16 + fr) * 4 + wc] = part[ai][m];
            }
            __syncthreads();
            const int tid = wid * 64 + lane;
            if (tid < 256) { const f32x4 t = *(const LAS f32x4*)(P + tid * 4); rstd[((size_t)(u.pm * BM + tid)) * 4 + u.pn] = (t.x + t.y) + (t.z + t.w); }
            __syncthreads();
        }
    }
};

template <class Epi, class Sched, bool ALIGN_EPI = false, bool SP2 = false>
__device__ __forceinline__ void gemm_phase(LAS unsigned char* lds, const Gemm g, const Sched S, const Epi E, int wid0) {
    int tid = wid0 * 64 + lane_id(); asm volatile("" : "+v"(tid));
    const int wid = __builtin_amdgcn_readfirstlane(tid >> 6), lane = tid & 63, wr = wid >> 2, wc = wid & 3, fr = lane & 15, fq = lane >> 4;
    const int K = g.K, nt = K / BK;
    unsigned voffA[2], voffB[2];
#pragma unroll
    for (int i = 0; i < 2; ++i) { int R, C; stage_rc(tid * 16 + i * 8192, R, C); const int Rb = Epi::PERM ? ((R & ~31) + perm32(R & 31)) : R;
        voffA[i] = (unsigned)(R * g.lda + C) * 2u; voffB[i] = (unsigned)(Rb * g.ldb + C) * 2u; }
    const size_t kstep = (size_t)(BK * 2);
    const size_t hstepA = (size_t)HALF * g.lda * 2, hstepB = (size_t)HALF * g.ldb * 2;
    const unsigned ldsw = (unsigned)wid * 1024u;
    const int aoff = lds_byte(wr * 64 + fr, fq * 8), boff = lds_byte(wc * 32 + fr, fq * 8);
#define PG8_UA(u) ((const char*)g.A + 2 * ((long)(u).pm * g.a_pm + (long)(u).pn * g.a_pn))
#define PG8_UB(u) ((const char*)g.Bt + 2 * ((long)(u).pn * g.b_pn + (long)((u).pm >> g.bshift) * g.b_pb))
#define PG8_SA(b, h) (((b) * 2 + (h)) * HTB)
#define PG8_SB(b, h) ((4 + (b) * 2 + (h)) * HTB)
#define PG8_STAGE(bufoff, gbase, voff) do { _Pragma("unroll") for (int _i = 0; _i < 2; ++_i) \
        __builtin_amdgcn_global_load_lds((const unsigned*)((const char*)(gbase) + (voff)[_i]), (LAS unsigned*)(lds + (bufoff) + ldsw + _i * 8192), 16, 0, 0); } while (0)
#define PG8_LDA(dst, b, h) do { _Pragma("unroll") for (int m = 0; m < 4; ++m) _Pragma("unroll") for (int k = 0; k < 2; ++k) dst[m][k] = *(const LAS bf16x8*)(lds + PG8_SA(b, h) + aoff + m * 2048 + k * 1024); } while (0)
#define PG8_LDB(dst, b, h) do { _Pragma("unroll") for (int n = 0; n < 2; ++n) _Pragma("unroll") for (int k = 0; k < 2; ++k) dst[n][k] = *(const LAS bf16x8*)(lds + PG8_SB(b, h) + boff + n * 2048 + k * 1024); } while (0)
#define PG8_MMA(ai, bj, At, Bt) do { __builtin_amdgcn_s_setprio(1); _Pragma("unroll") for (int m = 0; m < 4; ++m) _Pragma("unroll") for (int n = 0; n < 2; ++n) _Pragma("unroll") for (int k = 0; k < 2; ++k) \
        acc[ai][bj][m][n] = __builtin_amdgcn_mfma_f32_16x16x32_bf16(Bt[n][k], At[m][k], acc[ai][bj][m][n], 0, 0, 0); __builtin_amdgcn_s_setprio(0); } while (0)
#define PG8_WAIT_V(n) asm volatile("s_waitcnt vmcnt(" #n ")" ::: "memory")
#define PG8_WAIT_L(n) asm volatile("s_waitcnt lgkmcnt(" #n ")" ::: "memory")
#define PG8_BAR __builtin_amdgcn_s_barrier()
#define PG8_SCHED __builtin_amdgcn_sched_barrier(0)
    Unit cur, nxt; int ui = 0;
    if (!S.next(0, cur)) return;
    f32x4 acc[2][2][4][2];
#pragma unroll
    for (int a = 0; a < 2; ++a)
#pragma unroll
        for (int b = 0; b < 2; ++b)
#pragma unroll
            for (int m = 0; m < 4; ++m)
#pragma unroll
                for (int n = 0; n < 2; ++n) acc[a][b][m][n] = (f32x4){0.f, 0.f, 0.f, 0.f};
    bf16x8 At[4][2], B0[2][2], B1[2][2];
    const char* cA = PG8_UA(cur); const char* cB = PG8_UB(cur);
    if constexpr (SP2) {
        PG8_STAGE(PG8_SB(0, 0), cB, voffB); PG8_STAGE(PG8_SB(0, 1), cB + hstepB, voffB); PG8_STAGE(PG8_SA(0, 0), cA, voffA); PG8_STAGE(PG8_SA(0, 1), cA + hstepA, voffA);
        if (wr == 1) PG8_BAR;
        PG8_WAIT_V(2); PG8_BAR;
        PG8_STAGE(PG8_SB(1, 0), cB + kstep, voffB); PG8_STAGE(PG8_SA(1, 0), cA + kstep, voffA); PG8_STAGE(PG8_SB(1, 1), cB + hstepB + kstep, voffB);
        PG8_WAIT_V(6); PG8_BAR;
    } else {
        PG8_STAGE(PG8_SB(0, 0), cB, voffB); PG8_STAGE(PG8_SA(0, 0), cA, voffA); PG8_STAGE(PG8_SB(0, 1), cB + hstepB, voffB); PG8_STAGE(PG8_SA(0, 1), cA + hstepA, voffA);
        if (wr == 1) PG8_BAR;
        PG8_WAIT_V(4); PG8_BAR;
        PG8_STAGE(PG8_SB(1, 0), cB + kstep, voffB); PG8_STAGE(PG8_SA(1, 0), cA + kstep, voffA); PG8_STAGE(PG8_SB(1, 1), cB + hstepB + kstep, voffB);
        PG8_WAIT_V(6); PG8_BAR;
    }
    for (;;) {
        const bool has_next = S.next(ui + 1, nxt);
        const char* nA = has_next ? PG8_UA(nxt) : cA; const char* nB = has_next ? PG8_UB(nxt) : cB;
        for (int t = 0; t < nt; t += 2) {
            const bool last = (t == nt - 2);
            const char* a1 = cA + (size_t)(t + 1) * kstep;
            const char* a2 = last ? nA : cA + (size_t)(t + 2) * kstep; const char* b2 = last ? nB : cB + (size_t)(t + 2) * kstep;
            const char* a3 = a2 + kstep; const char* b3 = b2 + kstep;
            if constexpr (SP2) {
            PG8_LDB(B0, 0, 0); PG8_LDB(B1, 0, 1); PG8_SCHED; PG8_LDA(At, 0, 0); PG8_STAGE(PG8_SA(1, 1), a1 + hstepA, voffA);
            PG8_WAIT_V(8); PG8_WAIT_L(0); PG8_BAR; PG8_MMA(0, 0, At, B0); PG8_MMA(0, 1, At, B1); PG8_BAR; PG8_SCHED;
            PG8_LDA(At, 0, 1); PG8_STAGE(PG8_SB(0, 0), b2, voffB); PG8_STAGE(PG8_SB(0, 1), b2 + hstepB, voffB); PG8_STAGE(PG8_SA(0, 0), a2, voffA);
            PG8_WAIT_V(8); PG8_WAIT_L(0); PG8_BAR; PG8_MMA(1, 0, At, B0); PG8_MMA(1, 1, At, B1); PG8_BAR; PG8_SCHED;
            PG8_LDB(B0, 1, 0); PG8_LDB(B1, 1, 1); PG8_SCHED; PG8_LDA(At, 1, 0); PG8_STAGE(PG8_SA(0, 1), a2 + hstepA, voffA);
            PG8_WAIT_V(8); PG8_WAIT_L(0); PG8_BAR; PG8_MMA(0, 0, At, B0); PG8_MMA(0, 1, At, B1); PG8_BAR; PG8_SCHED;
            PG8_LDA(At, 1, 1); PG8_STAGE(PG8_SB(1, 0), b3, voffB); PG8_STAGE(PG8_SB(1, 1), b3 + hstepB, voffB); PG8_STAGE(PG8_SA(1, 0), a3, voffA);
            PG8_WAIT_V(8); PG8_WAIT_L(0); PG8_BAR; PG8_MMA(1, 0, At, B0); PG8_MMA(1, 1, At, B1); PG8_BAR; PG8_SCHED;
            } else {
            PG8_LDB(B0, 0, 0); PG8_SCHED; PG8_LDA(At, 0, 0); PG8_STAGE(PG8_SA(1, 1), a1 + hstepA, voffA);
            PG8_WAIT_L(8); PG8_BAR; PG8_WAIT_L(0); PG8_MMA(0, 0, At, B0); PG8_BAR; PG8_SCHED;
            PG8_LDB(B1, 0, 1); PG8_STAGE(PG8_SB(0, 0), b2, voffB);
            PG8_BAR; PG8_WAIT_L(0); PG8_MMA(0, 1, At, B1); PG8_BAR;
            PG8_LDA(At, 0, 1); PG8_STAGE(PG8_SA(0, 0), a2, voffA);
            PG8_BAR; PG8_WAIT_L(0); PG8_MMA(1, 0, At, B0); PG8_BAR; PG8_SCHED;
            PG8_STAGE(PG8_SB(0, 1), b2 + hstepB, voffB);
            PG8_WAIT_V(6); PG8_BAR; PG8_MMA(1, 1, At, B1); PG8_BAR;
            PG8_LDB(B0, 1, 0); PG8_SCHED; PG8_LDA(At, 1, 0); PG8_STAGE(PG8_SA(0, 1), a2 + hstepA, voffA);
            PG8_WAIT_L(8); PG8_BAR; PG8_WAIT_L(0); PG8_MMA(0, 0, At, B0); PG8_BAR; PG8_SCHED;
            PG8_LDB(B1, 1, 1); PG8_STAGE(PG8_SB(1, 0), b3, voffB);
            PG8_BAR; PG8_WAIT_L(0); PG8_MMA(0, 1, At, B1); PG8_BAR;
            PG8_LDA(At, 1, 1); PG8_STAGE(PG8_SA(1, 0), a3, voffA);
            PG8_BAR; PG8_WAIT_L(0); PG8_MMA(1, 0, At, B0); PG8_BAR; PG8_SCHED;
            PG8_STAGE(PG8_SB(1, 1), b3 + hstepB, voffB);
            PG8_WAIT_V(6); PG8_BAR; PG8_MMA(1, 1, At, B1); PG8_BAR;
            }
        }
        if constexpr (ALIGN_EPI) { if (wr == 0) PG8_BAR; }
        if constexpr (!Epi::AFTER_DRAIN) { E(acc, cur, wr, wc, fr, fq); }
        if (!has_next) break;
#pragma unroll
        for (int a = 0; a < 2; ++a)
#pragma unroll
            for (int b = 0; b < 2; ++b)
#pragma unroll
                for (int m = 0; m < 4; ++m)
#pragma unroll
                    for (int n = 0; n < 2; ++n) acc[a][b][m][n] = (f32x4){0.f, 0.f, 0.f, 0.f};
        cur = nxt; cA = nA; cB = nB; ++ui;
        if constexpr (ALIGN_EPI) { if (wr == 1) PG8_BAR; }
    }
    PG8_WAIT_V(0);
    if constexpr (!ALIGN_EPI) { if (wr == 0) PG8_BAR; }
    PG8_BAR;
    if constexpr (Epi::AFTER_DRAIN) { E.fused(acc, cur, wr, wc, fr, fq, lds, wid, lane); }
#undef PG8_UA
#undef PG8_UB
#undef PG8_SA
#undef PG8_SB
#undef PG8_STAGE
#undef PG8_LDA
#undef PG8_LDB
#undef PG8_MMA
#undef PG8_WAIT_V
#undef PG8_WAIT_L
#undef PG8_BAR
#undef PG8_SCHED
}
}

struct TItem { const float* W; bf16_t* WT; const float* gk; int K, N, drow0, k0, n0; bool valid; };
__device__ __forceinline__ void ti_load(const TItem& t, f32x4 (&v)[16], int lane) {
    const int lr = lane >> 4, lc = (lane & 15) * 4;
    if (t.valid) {
#pragma unroll
        for (int i = 0; i < 16; ++i) v[i] = *(const f32x4*)(t.W + (size_t)(t.k0 + 4 * i + lr) * t.N + t.n0 + lc);
    }
}
__device__ __forceinline__ void ti_finish(const TItem& t, f32x4 (&v)[16], LAS float* scr, int lane) {
    if (!t.valid) return;
    const int lr = lane >> 4, lc = (lane & 15) * 4;
    const int c = lane & 7;
    f32x4 g0 = (f32x4){1.f, 1.f, 1.f, 1.f}, g1 = g0;
    if (t.gk) { g0 = *(const f32x4*)(t.gk + t.k0 + 8 * c); g1 = *(const f32x4*)(t.gk + t.k0 + 8 * c + 4); }
#pragma unroll
    for (int i = 0; i < 16; ++i) { LAS float* s = scr + (4 * i + lr) * 65 + lc; s[0] = v[i].x; s[1] = v[i].y; s[2] = v[i].z; s[3] = v[i].w; }
    asm volatile("s_waitcnt lgkmcnt(0)" ::: "memory");
#pragma unroll
    for (int j = 0; j < 8; ++j) { const int n = (lane >> 3) + 8 * j; const LAS float* s = scr + (8 * c) * 65 + n;
        u32x4 o; o.x = cvt_pk_bf16(s[0 * 65] * g0.x, s[1 * 65] * g0.y); o.y = cvt_pk_bf16(s[2 * 65] * g0.z, s[3 * 65] * g0.w); o.z = cvt_pk_bf16(s[4 * 65] * g1.x, s[5 * 65] * g1.y); o.w = cvt_pk_bf16(s[6 * 65] * g1.z, s[7 * 65] * g1.w);
        *(u32x4*)(t.WT + (size_t)(t.drow0 + n) * t.K + t.k0 + 8 * c) = o; }
    asm volatile("s_waitcnt lgkmcnt(0)" ::: "memory");
}

template <bool HAS_Y, bool HAS_XN>
__device__ __forceinline__ void rowpass(const float* xin, float* xout, const bf16_t* Y, const float* gpost, float wgt, bf16_t* XN, const float* gpre, int nrows, int gw, int NGW, int lane_in) {
    int lane = lane_in; asm volatile("" : "+v"(lane));
    for (int m = gw; m < nrows; m += NGW) {
        const f32x4* xr = (const f32x4*)(xin + (size_t)m * DM) + lane;
        f32x4 v[4];
#pragma unroll
        for (int j = 0; j < 4; ++j) v[j] = xr[64 * j];
        if constexpr (HAS_Y) {
            const u32x2* yr = (const u32x2*)(Y + (size_t)m * DM) + lane;
            f32x4 y[4]; float ss = 0.f;
#pragma unroll
            for (int j = 0; j < 4; ++j) { const u32x2 w = yr[64 * j]; y[j] = (f32x4){bf_lo(w.x), bf_hi(w.x), bf_lo(w.y), bf_hi(w.y)};
                ss += (y[j].x * y[j].x + y[j].y * y[j].y) + (y[j].z * y[j].z + y[j].w * y[j].w); }
            ss = wave_sum(ss);
            const float rs = wgt / sqrtf(ss * (1.0f / DM) + EPS);
#pragma unroll
            for (int j = 0; j < 4; ++j) { const f32x4 g = ((const f32x4*)gpost)[lane + 64 * j]; v[j] = v[j] + y[j] * g * rs; }
        }
        if (xout) { f32x4* xo = (f32x4*)(xout + (size_t)m * DM) + lane;
#pragma unroll
            for (int j = 0; j < 4; ++j) xo[64 * j] = v[j]; }
        if constexpr (HAS_XN) {
            float s2 = 0.f;
#pragma unroll
            for (int j = 0; j < 4; ++j) s2 += (v[j].x * v[j].x + v[j].y * v[j].y) + (v[j].z * v[j].z + v[j].w * v[j].w);
            s2 = wave_sum(s2);
            const float rs2 = 1.0f / sqrtf(s2 * (1.0f / DM) + EPS);
            u32x2* xo = (u32x2*)(XN + (size_t)m * DM) + lane;
#pragma unroll
            for (int j = 0; j < 4; ++j) { const f32x4 g = ((const f32x4*)gpre)[lane + 64 * j]; const f32x4 o = v[j] * g * rs2;
                u32x2 w; w.x = cvt_pk_bf16(o.x, o.y); w.y = cvt_pk_bf16(o.z, o.w); xo[64 * j] = w; }
        }
    }
}

__device__ __forceinline__ void rowpass0(const float* xin, bf16_t* XB, float* rstd, int gw, int NGW, int lane_in) {
    int lane = lane_in; asm volatile("" : "+v"(lane));
    for (int m = gw; m < NTOK; m += 2 * NGW) {
        const int m2 = m + NGW;
        const f32x4* xr = (const f32x4*)(xin + (size_t)m * DM) + lane; const f32x4* xr2 = (const f32x4*)(xin + (size_t)m2 * DM) + lane;
        f32x4 va[4], vb[4];
#pragma unroll
        for (int j = 0; j < 4; ++j) { va[j] = xr[64 * j]; vb[j] = xr2[64 * j]; }
        u32x2* xo = (u32x2*)(XB + (size_t)m * DM) + lane; u32x2* xo2 = (u32x2*)(XB + (size_t)m2 * DM) + lane;
        float s2 = 0.f, t2 = 0.f;
#pragma unroll
        for (int j = 0; j < 4; ++j) {
            u32x2 w; w.x = cvt_pk_bf16(va[j].x, va[j].y); w.y = cvt_pk_bf16(va[j].z, va[j].w); xo[64 * j] = w;
            { const float a = bf_lo(w.x), b = bf_hi(w.x), c = bf_lo(w.y), d = bf_hi(w.y); s2 += (a * a + b * b) + (c * c + d * d); }
            u32x2 w2; w2.x = cvt_pk_bf16(vb[j].x, vb[j].y); w2.y = cvt_pk_bf16(vb[j].z, vb[j].w); xo2[64 * j] = w2;
            { const float a = bf_lo(w2.x), b = bf_hi(w2.x), c = bf_lo(w2.y), d = bf_hi(w2.y); t2 += (a * a + b * b) + (c * c + d * d); }
        }
        s2 = wave_sum(s2); t2 = wave_sum(t2);
        if (lane == 0) { *(f32x4*)(rstd + 4 * (size_t)m) = (f32x4){s2, 0.f, 0.f, 0.f}; *(f32x4*)(rstd + 4 * (size_t)m2) = (f32x4){t2, 0.f, 0.f, 0.f}; }
    }
}
__device__ __forceinline__ void wave_sum8(float (&v)[8]) {
#pragma unroll
    for (int i = 0; i < 8; ++i) v[i] += shx<1>(v[i]);
#pragma unroll
    for (int i = 0; i < 8; ++i) v[i] += shx<2>(v[i]);
#pragma unroll
    for (int i = 0; i < 8; ++i) v[i] += shx<4>(v[i]);
#pragma unroll
    for (int i = 0; i < 8; ++i) v[i] += shx<8>(v[i]);
#pragma unroll
    for (int i = 0; i < 8; ++i) v[i] += shx<16>(v[i]);
#pragma unroll
    for (int i = 0; i < 8; ++i) v[i] = sum32(v[i]);
}
__device__ __forceinline__ void light_mixers_tile(LAS unsigned char* lds, const bf16_t* Z, bf16_t* YC, int tl, const float* pool_w, const float* pool_scale, const float* sconv_w,
                                                  const float* dw_w, const float* dw_b, const float* ln_g, const float* ln_b, int wid0) {
    int tid = wid0 * 64 + lane_id(); asm volatile("" : "+v"(tid));
    const int lane = tid & 63, wid = tid >> 6;
    const int tok0 = tl * 64, s0 = tok0 % SEQ;
    float scw[3][8];
#pragma unroll
    for (int j = 0; j < 3; ++j)
#pragma unroll
        for (int i = 0; i < 8; ++i) scw[j][i] = sconv_w[j * 256 + (tid & 31) * 8 + i];
    u32x4 sco[4];
#pragma unroll
    for (int k = 0; k < 4; ++k) { const int it = tid + 512 * k;
        const int t = it >> 5, c8 = (it & 31) * 8; const int s = s0 + t; const bf16_t* zr = Z + (size_t)(tok0 + t) * ZLD;
        float xs[8], cgv[8], bg[8], p0[8], p1[8], p2[8];
        ld8(zr + 256 + c8, xs); ld8(zr + 768 + c8, cgv); ld8(zr + 512 + c8, bg);
#pragma unroll
        for (int i = 0; i < 8; ++i) p2[i] = xs[i] * cgv[i];
        if (s >= 1) { ld8(zr - ZLD + 256 + c8, xs); ld8(zr - ZLD + 768 + c8, cgv);
#pragma unroll
            for (int i = 0; i < 8; ++i) p1[i] = xs[i] * cgv[i]; }
        else {
#pragma unroll
            for (int i = 0; i < 8; ++i) p1[i] = 0.f; }
        if (s >= 2) { ld8(zr - 2 * ZLD + 256 + c8, xs); ld8(zr - 2 * ZLD + 768 + c8, cgv);
#pragma unroll
            for (int i = 0; i < 8; ++i) p0[i] = xs[i] * cgv[i]; }
        else {
#pragma unroll
            for (int i = 0; i < 8; ++i) p0[i] = 0.f; }
        float o[8];
#pragma unroll
        for (int i = 0; i < 8; ++i) o[i] = bg[i] * (scw[0][i] * p0[i] + scw[1][i] * p1[i] + scw[2][i] * p2[i]);
        u32x4 w; w.x = cvt_pk_bf16(o[0], o[1]); w.y = cvt_pk_bf16(o[2], o[3]); w.z = cvt_pk_bf16(o[4], o[5]); w.w = cvt_pk_bf16(o[6], o[7]);
        sco[k] = w;
    }
#pragma unroll
    for (int k = 0; k < 4; ++k) { const int it = tid + 512 * k; *(u32x4*)(YC + (size_t)(tok0 + (it >> 5)) * DM + 256 + (it & 31) * 8) = sco[k]; }
    LAS bf16_t* mxb = (LAS bf16_t*)lds;
    LAS bf16_t* wtb = (LAS bf16_t*)(lds + 34816);
    LAS bf16_t* zb = (LAS bf16_t*)(lds + 73728);
    {   u32x4 zr5[5];
#pragma unroll
        for (int k = 0; k < 5; ++k) { const int it = tid + 512 * k; const int i = it >> 5, c8 = (it & 31) * 8; const int s = s0 - 15 + i;
            zr5[k] = (u32x4){0u, 0u, 0u, 0u};
            if (it < 79 * 32 && s >= 0) zr5[k] = *(const u32x4*)(Z + (size_t)(tok0 - 15 + i) * ZLD + c8); }
#pragma unroll
        for (int k = 0; k < 5; ++k) { const int it = tid + 512 * k; if (it < 79 * 32) *(LAS u32x4*)(zb + (it >> 5) * 256 + (it & 31) * 8) = zr5[k]; }
    }
#pragma unroll
    for (int e0 = 0; e0 < 16384; e0 += 512 * 8) {
        float pw[8];
#pragma unroll
        for (int k = 0; k < 8; ++k) pw[k] = pool_w[e0 + 512 * k + tid];
#pragma unroll
        for (int k = 0; k < 8; ++k) { const int e = e0 + 512 * k + tid; const int g = e >> 12, c = (e >> 6) & 63, d = e & 63; wtb[(g * 64 + d) * 72 + c] = (bf16_t)(cvt_pk_bf16(pw[k], 0.f) & 0xffffu); }
    }
    __syncthreads();
    for (int it = tid; it < 64 * 32; it += 512) {
        const int t = it >> 5, c8 = (it & 31) * 8; const int s = s0 + t; const int g = c8 >> 6, w = 2 << g; const int cnt = (s + 1 < w) ? (s + 1) : w;
        float cur[8], sum[8];
        { const u32x4 q = *(const LAS u32x4*)(zb + (15 + t) * 256 + c8);
          cur[0] = bf_lo(q.x); cur[1] = bf_hi(q.x); cur[2] = bf_lo(q.y); cur[3] = bf_hi(q.y); cur[4] = bf_lo(q.z); cur[5] = bf_hi(q.z); cur[6] = bf_lo(q.w); cur[7] = bf_hi(q.w); }
#pragma unroll
        for (int i = 0; i < 8; ++i) sum[i] = cur[i];
        for (int j = 1; j < w; ++j) { const u32x4 q = *(const LAS u32x4*)(zb + (15 + t - j) * 256 + c8);
            sum[0] += bf_lo(q.x); sum[1] += bf_hi(q.x); sum[2] += bf_lo(q.y); sum[3] += bf_hi(q.y); sum[4] += bf_lo(q.z); sum[5] += bf_hi(q.z); sum[6] += bf_lo(q.w); sum[7] += bf_hi(q.w); }
        const float ic = 1.0f / (float)cnt;
        u32x4 o; o.x = cvt_pk_bf16(sum[0] * ic - cur[0], sum[1] * ic - cur[1]); o.y = cvt_pk_bf16(sum[2] * ic - cur[2], sum[3] * ic - cur[3]);
        o.z = cvt_pk_bf16(sum[4] * ic - cur[4], sum[5] * ic - cur[5]); o.w = cvt_pk_bf16(sum[6] * ic - cur[6], sum[7] * ic - cur[7]);
        *(LAS u32x4*)(mxb + t * 264 + c8) = o;
    }
    __syncthreads();
    {
        const int g = wid >> 1, tb = wid & 1, r32 = lane & 31, hi = lane >> 5;
        f32x16 acc0 = {}, acc1 = {};
#pragma unroll
        for (int ks = 0; ks < 4; ++ks) {
            const bf16x8 bm = *(const LAS bf16x8*)(mxb + (tb * 32 + r32) * 264 + g * 64 + ks * 16 + hi * 8);
            const bf16x8 a0 = *(const LAS bf16x8*)(wtb + (g * 64 + r32) * 72 + ks * 16 + hi * 8), a1 = *(const LAS bf16x8*)(wtb + (g * 64 + 32 + r32) * 72 + ks * 16 + hi * 8);
            acc0 = __builtin_amdgcn_mfma_f32_32x32x16_bf16(a0, bm, acc0, 0, 0, 0);
            acc1 = __builtin_amdgcn_mfma_f32_32x32x16_bf16(a1, bm, acc1, 0, 0, 0);
        }
        bf16_t* op = YC + (size_t)(tok0 + tb * 32 + r32) * DM + g * 64;
        f32x4 sav[4], sbv[4];
#pragma unroll
        for (int rg = 0; rg < 4; ++rg) { sav[rg] = *(const f32x4*)(pool_scale + g * 64 + 8 * rg + 4 * hi); sbv[rg] = *(const f32x4*)(pool_scale + g * 64 + 32 + 8 * rg + 4 * hi); }
#pragma unroll
        for (int rg = 0; rg < 4; ++rg) { const int d0 = 8 * rg + 4 * hi;
            const f32x4 sa = sav[rg], sb = sbv[rg];
            u32x2 wa, wb;
            wa.x = cvt_pk_bf16(acc0[4 * rg + 0] * sa.x, acc0[4 * rg + 1] * sa.y); wa.y = cvt_pk_bf16(acc0[4 * rg + 2] * sa.z, acc0[4 * rg + 3] * sa.w);
            wb.x = cvt_pk_bf16(acc1[4 * rg + 0] * sb.x, acc1[4 * rg + 1] * sb.y); wb.y = cvt_pk_bf16(acc1[4 * rg + 2] * sb.z, acc1[4 * rg + 3] * sb.w);
            *(u32x2*)(op + d0) = wa; *(u32x2*)(op + 32 + d0) = wb; }
    }
    __syncthreads();
    LAS bf16_t* ub = (LAS bf16_t*)lds; LAS float* cv = (LAS float*)(lds + 49152);
    {   u32x4 gaw[6], ggw[6];
#pragma unroll
        for (int k = 0; k < 6; ++k) { const int it = tid + 512 * k; const int i = it >> 5, c8 = (it & 31) * 8; const int s = s0 - 30 + i;
            gaw[k] = (u32x4){0u, 0u, 0u, 0u}; ggw[k] = gaw[k];
            if (it < 94 * 32 && s >= 0) { const bf16_t* zr = Z + (size_t)(tok0 - 30 + i) * ZLD; gaw[k] = *(const u32x4*)(zr + 1536 + c8); ggw[k] = *(const u32x4*)(zr + 1792 + c8); } }
#pragma unroll
        for (int k = 0; k < 6; ++k) { const int it = tid + 512 * k;
            float ga[8], gg[8], e[8];
            ga[0] = bf_lo(gaw[k].x); ga[1] = bf_hi(gaw[k].x); ga[2] = bf_lo(gaw[k].y); ga[3] = bf_hi(gaw[k].y); ga[4] = bf_lo(gaw[k].z); ga[5] = bf_hi(gaw[k].z); ga[6] = bf_lo(gaw[k].w); ga[7] = bf_hi(gaw[k].w);
            gg[0] = bf_lo(ggw[k].x); gg[1] = bf_hi(ggw[k].x); gg[2] = bf_lo(ggw[k].y); gg[3] = bf_hi(ggw[k].y); gg[4] = bf_lo(ggw[k].z); gg[5] = bf_hi(ggw[k].z); gg[6] = bf_lo(ggw[k].w); gg[7] = bf_hi(ggw[k].w);
#pragma unroll
            for (int q = 0; q < 8; ++q) e[q] = fast_exp2(-1.4426950408889634f * gg[q]);
#pragma unroll
            for (int q = 0; q < 8; ++q) e[q] = fast_rcp(1.0f + e[q]);
#pragma unroll
            for (int q = 0; q < 8; ++q) e[q] *= ga[q];
            u32x4 w; w.x = cvt_pk_bf16(e[0], e[1]); w.y = cvt_pk_bf16(e[2], e[3]); w.z = cvt_pk_bf16(e[4], e[5]); w.w = cvt_pk_bf16(e[6], e[7]);
            if (it < 94 * 32) *(LAS u32x4*)(ub + (it >> 5) * 256 + (it & 31) * 8) = w; }
    }
    __syncthreads();
    {
        const int ch = tid & 255, half = tid >> 8;
        float wt[31];
#pragma unroll
        for (int j = 0; j < 31; ++j) wt[j] = dw_w[j * 256 + ch];
        const float bias = dw_b[ch];
        float uu[62];
#pragma unroll
        for (int i = 0; i < 62; ++i) uu[i] = bf2f(ub[(half * 32 + i) * 256 + ch]);
#pragma unroll
        for (int t = 0; t < 32; ++t) {
            float a = bias;
#pragma unroll
            for (int j = 0; j < 31; ++j) a += wt[j] * uu[t + j];
            cv[(half * 32 + t) * 256 + ch] = a;
        }
    }
    __syncthreads();
    {
        const f32x4 g4 = ((const f32x4*)ln_g)[lane], b4 = ((const f32x4*)ln_b)[lane];
        f32x4 v[8]; float sm[8];
#pragma unroll
        for (int i = 0; i < 8; ++i) { v[i] = *(const LAS f32x4*)(cv + (wid * 8 + i) * 256 + 4 * lane); sm[i] = (v[i].x + v[i].y) + (v[i].z + v[i].w); }
        wave_sum8(sm);
#pragma unroll
        for (int i = 0; i < 8; ++i) { v[i] = v[i] - sm[i] * (1.0f / 256.0f); sm[i] = (v[i].x * v[i].x + v[i].y * v[i].y) + (v[i].z * v[i].z + v[i].w * v[i].w); }
        wave_sum8(sm);
        u32x2 ow[8];
#pragma unroll
        for (int i = 0; i < 8; ++i) { const float rs = __builtin_amdgcn_rsqf(sm[i] * (1.0f / 256.0f) + EPS);
            const f32x4 y = v[i] * rs * g4 + b4;
            float e0 = fast_exp2(-1.4426950408889634f * y.x), e1 = fast_exp2(-1.4426950408889634f * y.y), e2 = fast_exp2(-1.4426950408889634f * y.z), e3 = fast_exp2(-1.4426950408889634f * y.w);
            e0 = fast_rcp(1.0f + e0); e1 = fast_rcp(1.0f + e1); e2 = fast_rcp(1.0f + e2); e3 = fast_rcp(1.0f + e3);
            ow[i].x = cvt_pk_bf16(y.x * e0, y.y * e1); ow[i].y = cvt_pk_bf16(y.z * e2, y.w * e3); }
#pragma unroll
        for (int i = 0; i < 8; ++i) *(u32x2*)(YC + (size_t)(tok0 + wid * 8 + i) * DM + 768 + 4 * lane) = ow[i];
    }
    __syncthreads();
}

constexpr int DA_KST = 144, DA_VST = 272, DA_KB = 128 * DA_KST, DA_VB = 64 * DA_VST, DA_BUF = DA_KB + DA_VB;
__device__ __forceinline__ float fadd_s(float a, float b) { float r; asm("v_add_f32_e32 %0, %1, %2" : "=v"(r) : "v"(a), "v"(b)); return r; }
template <int NH, bool FIRST>
__device__ __forceinline__ float da_step(const LAS unsigned char* kb, int kroff, int vroff, const bf16x8 (&qr)[2], f32x16& o0, f32x16& o1, f32x16& osum, f32x16& negm, float& mhat) {
    const bf16x8 ones = (bf16x8){0x3F80, 0x3F80, 0x3F80, 0x3F80, 0x3F80, 0x3F80, 0x3F80, 0x3F80};
    float rmax = -INFINITY;
#pragma unroll
    for (int g = 0; g < NH; ++g) {
        const LAS unsigned char* kg = kb + kroff + g * 64 * DA_KST;
        const bf16x8 k0 = *(const LAS bf16x8*)(kg), k1 = *(const LAS bf16x8*)(kg + 32 * DA_KST);
        const bf16x8 k2 = *(const LAS bf16x8*)(kg + 32), k3 = *(const LAS bf16x8*)(kg + 32 * DA_KST + 32);
        f32x16 pa = __builtin_amdgcn_mfma_f32_32x32x16_bf16(k0, qr[0], negm, 0, 0, 0);
        f32x16 pc = __builtin_amdgcn_mfma_f32_32x32x16_bf16(k1, qr[0], negm, 0, 0, 0);
        pa = __builtin_amdgcn_mfma_f32_32x32x16_bf16(k2, qr[1], pa, 0, 0, 0);
        pc = __builtin_amdgcn_mfma_f32_32x32x16_bf16(k3, qr[1], pc, 0, 0, 0);
        bf16x8 vfa[2][2], vfb[2][2];
#pragma unroll
        for (int hh = 0; hh < 2; ++hh)
#pragma unroll
            for (int s = 0; s < 2; ++s) { const LAS unsigned char* vp = kb + DA_KB + vroff + (2 * g + hh) * 64 + s * 32;
                vfa[hh][s] = *(const LAS bf16x8*)(vp); vfb[hh][s] = *(const LAS bf16x8*)(vp + 32 * DA_VST); }
        __builtin_amdgcn_sched_barrier(0);
        if constexpr (FIRST) {
            if (g == 0) {
                float ra = fmaxf(fmaxf(pa[0], pa[1]), pc[0]), rb = fmaxf(fmaxf(pa[2], pa[3]), pc[1]);
                ra = fmaxf(fmaxf(ra, pc[2]), pc[3]);
#pragma unroll
                for (int r = 4; r < 16; r += 4) { ra = fmaxf(fmaxf(ra, pa[r]), pa[r + 1]); rb = fmaxf(fmaxf(rb, pa[r + 2]), pa[r + 3]); ra = fmaxf(fmaxf(ra, pc[r]), pc[r + 1]); rb = fmaxf(fmaxf(rb, pc[r + 2]), pc[r + 3]); }
                rmax = fmaxf(ra, rb);
            }
        }
        if constexpr (FIRST) {
            if (g == 0) {
                const float ra = max32(rmax); mhat = ra; rmax = 0.f;
#pragma unroll
                for (int r = 0; r < 16; ++r) { pa[r] -= ra; pc[r] -= ra; negm[r] = -mhat; }
            }
        }
#pragma unroll
        for (int r = 0; r < 16; r += 2) { pa[r] = fast_exp2(pa[r]); pa[r + 1] = fast_exp2(pa[r + 1]); }
#pragma unroll
        for (int r = 0; r < 16; r += 2) { pc[r] = fast_exp2(pc[r]); pc[r + 1] = fast_exp2(pc[r + 1]); }
        bf16x8 pb[2][2];
#pragma unroll
        for (int hh = 0; hh < 2; ++hh)
#pragma unroll
            for (int s = 0; s < 2; ++s) { const f32x16& q = hh ? pc : pa; u32x4 w;
                w.x = cvtpk_s(q[8 * s + 0], q[8 * s + 1]); w.y = cvtpk_s(q[8 * s + 2], q[8 * s + 3]); w.z = cvtpk_s(q[8 * s + 4], q[8 * s + 5]); w.w = cvtpk_s(q[8 * s + 6], q[8 * s + 7]);
                pb[hh][s] = __builtin_bit_cast(bf16x8, w); }
#pragma unroll
        for (int hh = 0; hh < 2; ++hh)
#pragma unroll
            for (int s = 0; s < 2; ++s) {
                o0 = __builtin_amdgcn_mfma_f32_32x32x16_bf16(vfa[hh][s], pb[hh][s], o0, 0, 0, 0);
                o1 = __builtin_amdgcn_mfma_f32_32x32x16_bf16(vfb[hh][s], pb[hh][s], o1, 0, 0, 0);
                osum = __builtin_amdgcn_mfma_f32_32x32x16_bf16(ones, pb[hh][s], osum, 0, 0, 0);
            }
    }
    return rmax;
}
__device__ __forceinline__ void dattn_unit(LAS unsigned char* lds, const bf16_t* QC, const bf16_t* VT, bf16_t* YC, int b, int h, int u128, float lam, float oscale, const float* subg, int wid0) {
    int tid = wid0 * 64 + lane_id(); asm volatile("" : "+v"(tid));
    const int lane = tid & 63, r32 = lane & 31, hi = lane >> 5; const int wid = __builtin_amdgcn_readfirstlane(tid >> 6);
    const int comp = wid >> 2, wq = wid & 3;
    const size_t tok0 = (size_t)b * SEQ; const int q0 = u128 * 128;
    const bf16_t* KC = QC + (size_t)8 * 8192 * 64;
    const bf16_t* qp = QC + ((size_t)(b * 4 + h) * 8192 + q0 + wq * 32 + r32) * 64 + comp * 32 + hi * 8;
    bf16x8 qr[2]; qr[0] = *(const bf16x8*)qp; qr[1] = *(const bf16x8*)(qp + 16);
    const int NS = u128 + 1;
    const int srow = tid >> 3, sch = tid & 7;
    const bf16_t* ksrc = KC + ((size_t)(b * 4 + h) * 8192 + srow) * 64 + sch * 8;
    const bf16_t* vsrc = VT + (size_t)(h * 64 + srow) * NTOK + tok0 + sch * 8;
    const int kwoff = srow * DA_KST + sch * 16, vwoff = DA_KB + srow * DA_VST + sch * 16;
    const int rsw = (r32 & 0x13) | ((r32 & 4) << 1) | ((r32 & 8) >> 1);
    const int kroff = rsw * DA_KST + comp * 64 + hi * 16;
    const int vroff = r32 * DA_VST + hi * 16;
    f32x16 o0 = {}, o1 = {}, osum = {}; float mhat = 0.f;
    f32x16 negm = {};
    {   const u32x4 k0 = *(const u32x4*)ksrc, k1 = *(const u32x4*)(ksrc + 64 * 64), v0 = *(const u32x4*)vsrc, v1 = *(const u32x4*)(vsrc + 64);
        *(LAS u32x4*)(lds + kwoff) = k0; *(LAS u32x4*)(lds + kwoff + 64 * DA_KST) = k1; *(LAS u32x4*)(lds + vwoff) = v0; *(LAS u32x4*)(lds + vwoff + 128) = v1; }
    __syncthreads();
    for (int s = 0; s < NS; ++s) {
        const bool more = (s + 1 < NS);
        u32x4 k0 = (u32x4){0u, 0u, 0u, 0u}, k1 = k0, v0 = k0, v1 = k0;
        if (more) { const bf16_t* kp = ksrc + (size_t)(s + 1) * 128 * 64; const bf16_t* vp = vsrc + (size_t)(s + 1) * 128;
            k0 = *(const u32x4*)kp; k1 = *(const u32x4*)(kp + 64 * 64); v0 = *(const u32x4*)vp; v1 = *(const u32x4*)(vp + 64); }
        const LAS unsigned char* kb = lds + (s & 1) * DA_BUF;
        if ((s & 1) == 0 && s > 0 && __builtin_expect(__any(osum[0] > 16777216.f), 0)) {
            asm volatile("" ::: "memory");
            const float dl = fmaxf(floorf(__log2f(fmaxf(osum[0], 1.0f))), 0.f); const float alpha = fast_exp2(-dl); mhat += dl;
#pragma unroll
            for (int r = 0; r < 16; ++r) { o0[r] *= alpha; o1[r] *= alpha; osum[r] *= alpha; negm[r] = -mhat; }
        }
        if (s == 0) { if (more || wq >= 2) (void)da_step<2, true>(kb, kroff, vroff, qr, o0, o1, osum, negm, mhat); else (void)da_step<1, true>(kb, kroff, vroff, qr, o0, o1, osum, negm, mhat); }
        else if (more || wq >= 2) (void)da_step<2, false>(kb, kroff, vroff, qr, o0, o1, osum, negm, mhat);
        else (void)da_step<1, false>(kb, kroff, vroff, qr, o0, o1, osum, negm, mhat);
        if (more) { LAS unsigned char* nb = lds + ((s + 1) & 1) * DA_BUF;
            *(LAS u32x4*)(nb + kwoff) = k0; *(LAS u32x4*)(nb + kwoff + 64 * DA_KST) = k1; *(LAS u32x4*)(nb + vwoff) = v0; *(LAS u32x4*)(nb + vwoff + 128) = v1; }
        __syncthreads();
    }
    const float inv = 1.0f / osum[0];
    LAS float* X = (LAS float*)lds;
    if (comp == 1) {
        const float f = inv * lam;
#pragma unroll
        for (int r = 0; r < 16; ++r) { X[((wq * 2 + 0) * 16 + r) * 64 + lane] = o0[r] * f; X[((wq * 2 + 1) * 16 + r) * 64 + lane] = o1[r] * f; }
    }
    __syncthreads();
    if (comp == 0) {
        float ss = 0.f;
#pragma unroll
        for (int r = 0; r < 16; ++r) { o0[r] = o0[r] * inv - X[((wq * 2 + 0) * 16 + r) * 64 + lane]; o1[r] = o1[r] * inv - X[((wq * 2 + 1) * 16 + r) * 64 + lane]; ss += o0[r] * o0[r] + o1[r] * o1[r]; }
        ss = sum32(ss);
        float li_ = oscale; asm volatile("" : "+v"(li_));
        const float rs = (1.0f - li_) / sqrtf(ss * (1.0f / 64.0f) + EPS);
        bf16_t* op = YC + (tok0 + q0 + wq * 32 + r32) * DM + 512 + h * 64;
        f32x4 gav[4], gbv[4];
#pragma unroll
        for (int rg = 0; rg < 4; ++rg) { gav[rg] = *(const f32x4*)(subg + 8 * rg + 4 * hi); gbv[rg] = *(const f32x4*)(subg + 32 + 8 * rg + 4 * hi); }
#pragma unroll
        for (int rg = 0; rg < 4; ++rg) {
            const int d0 = 8 * rg + 4 * hi;
            const f32x4 ga = gav[rg], gb = gbv[rg];
            u32x2 wa, wb;
            wa.x = cvt_pk_bf16(o0[4 * rg + 0] * rs * ga.x, o0[4 * rg + 1] * rs * ga.y); wa.y = cvt_pk_bf16(o0[4 * rg + 2] * rs * ga.z, o0[4 * rg + 3] * rs * ga.w);
            wb.x = cvt_pk_bf16(o1[4 * rg + 0] * rs * gb.x, o1[4 * rg + 1] * rs * gb.y); wb.y = cvt_pk_bf16(o1[4 * rg + 2] * rs * gb.z, o1[4 * rg + 3] * rs * gb.w);
            *(u32x2*)(op + d0) = wa; *(u32x2*)(op + 32 + d0) = wb;
        }
    }
    __syncthreads();
}


#define XB_TMO      128
#define XB_XCNT(j)  (256  + 64 * (j))
#define XB_XSUB(j)  (1280 + 64 * (j))
#define XB_XGEN(j)  (2304 + 64 * (j))
#define XB_TOP      3328
#define XB_TOPGEN   3392
#define XCD_BAR_WORDS 3456
#define XB_SPIN_CAP (1u << 18)
__device__ __forceinline__ unsigned xb_ld(unsigned* p)              { return __hip_atomic_load(p, __ATOMIC_RELAXED, __HIP_MEMORY_SCOPE_AGENT); }
__device__ __forceinline__ unsigned xb_add(unsigned* p, unsigned v) { return __hip_atomic_fetch_add(p, v, __ATOMIC_RELAXED, __HIP_MEMORY_SCOPE_AGENT); }
__device__ __forceinline__ unsigned xb_xcc_id() { return (unsigned)__builtin_amdgcn_s_getreg((3 << 11) | 20) & 0xFu; }
#define XB_SPIN(cond, bar) do { unsigned _sp = 0; while (cond) { __builtin_amdgcn_s_sleep(1); \
    if ((++_sp & 255u) == 0u) { if (xb_ld(&(bar)[XB_TMO])) break; if (_sp > XB_SPIN_CAP) { atomicAdd(&(bar)[XB_TMO], 1u); break; } } } } while (0)
struct XcdBarrier { unsigned* bar; unsigned x; volatile LAS unsigned* st; };
__device__ __forceinline__ XcdBarrier xcd_barrier_post(unsigned* bar, volatile LAS unsigned* st) {
    XcdBarrier b; b.bar = bar; b.x = xb_xcc_id(); b.st = st;
    if (threadIdx.x == 0) (void)xb_add(&bar[XB_XCNT(b.x)], 1u);
    return b;
}
__device__ __forceinline__ void xcd_barrier_complete(unsigned* bar, unsigned x, unsigned& nloc, unsigned& nx) {
    const unsigned G = gridDim.x * gridDim.y * gridDim.z;
    unsigned sum, cnt, mine, sp = 0u;
    for (;;) {
        sum = 0u; cnt = 0u; mine = 0u;
#pragma unroll
        for (unsigned j = 0; j < 16; ++j) { const unsigned c = xb_ld(&bar[XB_XCNT(j)]); sum += c; cnt += (c > 0u) ? 1u : 0u; mine = (j == x) ? c : mine; }
        if (sum == G) break;
        __builtin_amdgcn_s_sleep(1);
        if ((++sp & 255u) == 0u) { if (xb_ld(&bar[XB_TMO])) break; if (sp > XB_SPIN_CAP) { atomicAdd(&bar[XB_TMO], 1u); break; } }
    }
    nloc = mine > 0u ? mine : 1u; nx = cnt > 0u ? cnt : 1u;
}
__device__ __forceinline__ void xcd_barrier(const XcdBarrier& b, int wid0) {
    asm volatile("s_waitcnt vmcnt(0)" ::: "memory");
    __syncthreads();
    if (wid0 == 0 && lane_id() == 0) {
        unsigned* bar = b.bar;
        __builtin_amdgcn_s_waitcnt(0);
        unsigned nloc = b.st[0], nx = b.st[1];
        if (nloc == 0u) { xcd_barrier_complete(bar, b.x, nloc, nx); b.st[0] = nloc; b.st[1] = nx; }
        const unsigned old = xb_add(&bar[XB_XSUB(b.x)], 1u);
        const unsigned gen = old / nloc;
        if (old + 1u == (gen + 1u) * nloc) {
            __builtin_amdgcn_fence(__ATOMIC_RELEASE, "agent");
            asm volatile("s_waitcnt vmcnt(0)" ::: "memory");
            const unsigned og = xb_add(&bar[XB_TOP], 1u);
            const unsigned tg = og / nx;
            if (og + 1u == (tg + 1u) * nx) xb_add(&bar[XB_TOPGEN], 1u);
            else XB_SPIN(xb_ld(&bar[XB_TOPGEN]) == tg, bar);
            __builtin_amdgcn_fence(__ATOMIC_ACQUIRE, "agent");
            xb_add(&bar[XB_XGEN(b.x)], 1u);
            asm volatile("s_waitcnt vmcnt(0)" ::: "memory");
        } else {
            XB_SPIN(xb_ld(&bar[XB_XGEN(b.x)]) == gen, bar);
            __builtin_amdgcn_fence(__ATOMIC_ACQUIRE, "agent");
            asm volatile("s_waitcnt vmcnt(0)" ::: "memory");
        }
    }
    __syncthreads();
}

#define IN(k) ld_ptr(ptab, (k))
__device__ __forceinline__ TItem decode_item(int slot, int idx, int total, volatile LAS unsigned long long* ptab, bf16_t* Wb) {
    TItem t; t.valid = idx < total; t.W = nullptr; t.WT = nullptr; t.gk = nullptr; t.K = 0; t.N = 0; t.drow0 = 0; t.k0 = 0; t.n0 = 0;
    if (!t.valid) return t;
    int l, r;
    if (slot == 0) { if (idx < 2112) { l = 0; r = idx; } else if (idx < 3968) { l = 0; r = idx + 2112; } else { l = 1; r = idx - 3968 + 5312; } }
    else if (slot == 1) { l = 0; r = idx + 2112; }
    else if (slot == 2) { l = 1; r = (idx < 2112) ? idx : idx + 2112; }
    else if (slot == 3) { l = 1; r = idx + 5824; }
    else { l = 1; r = idx + 2112; }
    bf16_t* Wl = Wb + (size_t)l * LW;
    const float* src; int K, N; bf16_t* dst; int kind; int gi = -1;
    if (r < 704) { src = IN(4) + (size_t)l * DM * FF; K = DM; N = FF; dst = Wl + OW_GU1; kind = 1; gi = 3; }
    else if (r < 1408) { r -= 704; src = IN(5) + (size_t)l * DM * FF; K = DM; N = FF; dst = Wl + OW_GU1; kind = 2; gi = 3; }
    else if (r < 2112) { r -= 1408; src = IN(6) + (size_t)l * DM * FF; K = FF; N = DM; dst = Wl + OW_D1; kind = 0; }
    else if (r < 2816) { r -= 2112; src = IN(32) + (size_t)l * DM * FF; K = DM; N = FF; dst = Wl + OW_GU2; kind = 1; gi = 31; }
    else if (r < 3520) { r -= 2816; src = IN(33) + (size_t)l * DM * FF; K = DM; N = FF; dst = Wl + OW_GU2; kind = 2; gi = 31; }
    else if (r < 4224) { r -= 3520; src = IN(34) + (size_t)l * DM * FF; K = FF; N = DM; dst = Wl + OW_D2; kind = 0; }
    else if (r < 4800) { r -= 4224; src = IN(9) + (size_t)l * DM * 2304; K = DM; N = 2304; dst = Wl + OW_IN; kind = 3; gi = 8; }
    else if (r < 5056) { r -= 4800; src = IN(22) + (size_t)l * DM * DM; K = DM; N = DM; dst = Wl + OW_O; kind = 0; }
    else if (r < 5312) { r -= 5056; src = IN(26) + (size_t)l * DM * DM; K = DM; N = DM; dst = Wl + OW_Q; kind = 0; gi = 24; }
    else if (r < 5568) { r -= 5312; src = IN(27) + (size_t)l * DM * DM; K = DM; N = DM; dst = Wl + OW_K; kind = 0; }
    else if (r < 5824) { r -= 5568; src = IN(28) + (size_t)l * DM * DM; K = DM; N = DM; dst = Wl + OW_V; kind = 0; }
    else { r -= 5824; src = IN(29) + (size_t)l * DM * DM; K = DM; N = DM; dst = Wl + OW_XO; kind = 0; }
    const int nblk = N / 64, kb = r / nblk, nb = r % nblk, n0 = 64 * nb;
    int drow0 = n0;
    if (kind == 1) drow0 = (n0 >> 7) * 256 + (n0 & 127);
    else if (kind == 2) drow0 = (n0 >> 7) * 256 + 128 + (n0 & 127);
    else if (kind == 3) { if (n0 >= 1792) drow0 = n0 - 256; else if (n0 >= 1536) drow0 = n0 + 512; }
    if (gi >= 0) t.gk = IN(gi) + l * DM;
    t.W = src; t.WT = dst; t.K = K; t.N = N; t.drow0 = drow0; t.k0 = 64 * kb; t.n0 = n0;
    return t;
}
__device__ __forceinline__ void convert_slot(int slot, int part, int nparts, volatile LAS unsigned long long* ptab, bf16_t* Wb, LAS unsigned char* lds, int wid) {
    const int total = (slot == 0) ? 4480 : (slot == 1) ? 2112 : (slot == 2) ? 3200 : (slot == 3) ? 256 : 2112;
    LAS float* scr = (LAS float*)(lds + wid * 16640);
    int lane = lane_id(); asm volatile("" : "+v"(lane));
    for (int idx0 = part; idx0 < total; idx0 += 2 * nparts) {
        TItem ta, tb; f32x4 va[16], vb[16];
        ta = decode_item(slot, idx0, total, ptab, Wb); tb = decode_item(slot, idx0 + nparts, total, ptab, Wb);
        ti_load(ta, va, lane); ti_load(tb, vb, lane);
        ti_finish(ta, va, scr, lane); ti_finish(tb, vb, scr, lane);
    }
}
#undef IN

__global__ void __launch_bounds__(512, 2) mega_fwd(Params p) {
    extern __shared__ __attribute__((aligned(16))) unsigned char lds_raw[];
    LAS unsigned char* lds = (LAS unsigned char*)lds_raw;
    cg::grid_group grid = cg::this_grid();
    const int wid = __builtin_amdgcn_readfirstlane((int)(threadIdx.x >> 6));
    const int tid = wid * 64 + lane_id();
    const int G = gridDim.x, bx = blockIdx.x;
    const int gw = bx * 8 + wid, NGW = G * 8;
    unsigned char* ws = p.ws;
    bf16_t* Wb = (bf16_t*)(ws + WS_W);
    bf16_t* XN = (bf16_t*)(ws + WS_XN);
    bf16_t* BIG = (bf16_t*)(ws + WS_BIG);
    bf16_t* Yb = (bf16_t*)(ws + WS_Y);
    bf16_t* KV = (bf16_t*)(ws + WS_KV);
    float* RSTD = (float*)(ws + WS_CTL + 131072 + 524288);
    float* SLOTS = (float*)(ws + WS_CTL + 131072);
    unsigned* PCNT = (unsigned*)(ws + WS_CTL + 16384);
    unsigned xk = 0;
#define GSYNC() xcd_barrier(bar, wid)
#define LSYNC() do { asm volatile("s_waitcnt vmcnt(0)" ::: "memory"); __builtin_amdgcn_fence(__ATOMIC_RELEASE, "workgroup"); __syncthreads(); __builtin_amdgcn_fence(__ATOMIC_ACQUIRE, "workgroup"); } while (0)
    volatile LAS unsigned long long* ptab = (volatile LAS unsigned long long*)(lds + 146432 + 128);
    volatile LAS unsigned* bst = (volatile LAS unsigned*)(lds + 146432);
    if (tid == 0) { bst[0] = 0u; bst[1] = 0u; }
    if (tid < 64) { for (int k = bx; k < 256; k += G) ((unsigned*)(ws + WS_CTL))[k * 64 + tid] = 0u; }
    if (tid == 0) {
#pragma unroll
        for (int i = 0; i < 36; ++i) ptab[i] = (unsigned long long)p.in[i];
    }
    __syncthreads();
#define IN(k) ld_ptr(ptab, (k))
    grid.sync();
    XcdBarrier bar = xcd_barrier_post((unsigned*)(ws + WS_CTL), bst);

    {
        convert_slot(0, gw, NGW, ptab, Wb, lds, wid);
        rowpass0(IN(0), XN, RSTD, gw, NGW, lane_id());
        rowpass<false, true>(IN(1), nullptr, nullptr, nullptr, 0.f, Yb, IN(25), 512, gw, NGW, lane_id());
        rowpass<false, true>(IN(1), nullptr, nullptr, nullptr, 0.f, Yb + 512 * DM, IN(25) + DM, 512, gw, NGW, lane_id());
    }
    GSYNC();

#pragma unroll 1
    for (int l = 0; l < 2; ++l) {
        const bf16_t* Wl = Wb + (size_t)l * LW;
        const bf16_t* KX = KV + (size_t)l * 1048576; const bf16_t* VXT = KX + 524288;
#pragma unroll 1
        for (int ff = 0; ff < 2; ++ff) {
            if (ff == 1) {
                {
                    pg8::Gemm g = pg8::make_gemm(XN, Wl + OW_IN, NTOK, ZLD, DM, DM, DM);
                    pg8::StaticOrder S; S.init(NTOK, ZLD, G, bx);
                    pg8::EpiWin E{BIG, ZLD, (const int*)IN(2), 0.25503486f, RSTD, BIG + (size_t)NTOK * ZLD + (size_t)256 * NTOK};
                    pg8::gemm_phase<pg8::EpiWin, pg8::StaticOrder, true, true>(lds, g, S, E, wid);
                }
                {
                    pg8::Gemm g = pg8::make_gemm(Wl + OW_IN + (size_t)2048 * DM, XN, 256, NTOK, DM, DM, DM);
                    pg8::StaticOrder S; S.init(256, NTOK, G, bx);
                    pg8::EpiOutCS E{BIG + (size_t)NTOK * ZLD, NTOK, 1.0f, nullptr, RSTD};
                    pg8::gemm_phase<pg8::EpiOutCS, pg8::StaticOrder, true, true>(lds, g, S, E, wid);
                    if (l == 0) {
#pragma unroll 1
                        for (int i = 0; i < 4; ++i) {
                            const int lk = i >> 1, isv = i & 1;
                            const bf16_t* MN = Yb + (size_t)lk * 512 * DM; const bf16_t* Wk = Wb + (size_t)lk * LW;
                            pg8::Gemm gk = isv ? pg8::make_gemm(Wk + OW_V, MN, DM, 512, DM, DM, DM) : pg8::make_gemm(MN, Wk + OW_K, 512, DM, DM, DM, DM);
                            pg8::StaticOrder Sk; Sk.init(gk.M, gk.N, G, (bx + 2 * G - 64 - 8 * i) % G);
                            pg8::EpiOut Ek{KV + (size_t)lk * 1048576 + (isv ? 524288 : 0), isv ? 512 : DM, 1.0f, nullptr, nullptr};
                            pg8::gemm_phase<pg8::EpiOut, pg8::StaticOrder, true, true>(lds, gk, Sk, Ek, wid);
                        }
                        if (bx >= 96) convert_slot(2, (bx - 96) * 8 + wid, 160 * 8, ptab, Wb, lds, wid);
                    }
                }
                GSYNC();
                {
                    bf16_t* YC = Yb; const bf16_t* Z = BIG; const bf16_t* VT = BIG + (size_t)NTOK * ZLD;
#ifdef PROBE_LM2
                    for (int rep = 0; rep < 2; ++rep)
#endif
                    for (int tl = bx; tl < 256; tl += G)
                        light_mixers_tile(lds, Z, YC, tl, IN(10) + (size_t)l * 16384, IN(11) + l * 256, IN(12) + l * 768, IN(18) + l * 31 * 256, IN(19) + l * 256, IN(20) + l * 256, IN(21) + l * 256, wid);
                    float d1 = 0.f, d2 = 0.f;
                    int lane_l = lane_id(); asm volatile("" : "+v"(lane_l));
                    if (lane_l < 32) { d1 = IN(13)[l * 32 + lane_l] * IN(14)[l * 32 + lane_l]; d2 = IN(15)[l * 32 + lane_l] * IN(16)[l * 32 + lane_l]; }
                    d1 = wave_sum(d1); d2 = wave_sum(d2);
                    const float lam_init = __uint_as_float((unsigned)__builtin_amdgcn_readfirstlane((l == 0) ? (int)0x3e4ccccd : (int)0x3eb60549));
                    const float lam = __uint_as_float((unsigned)__builtin_amdgcn_readfirstlane((int)__float_as_uint(expf(d1) - expf(d2) + lam_init)));
                    const float osc = __uint_as_float((unsigned)__builtin_amdgcn_readfirstlane((int)__float_as_uint(1.0f - lam_init)));
#ifdef PROBE_ATT2
                    for (int rep = 0; rep < 2; ++rep)
#endif
                    for (int pr = bx; pr < 256; pr += G) {
                        const int bh = pr & 7, s = pr >> 3;
                        dattn_unit(lds, VT + (size_t)256 * NTOK, VT, YC, bh >> 2, bh & 3, s, lam, lam_init, IN(17) + l * 64, wid);
                        dattn_unit(lds, VT + (size_t)256 * NTOK, VT, YC, bh >> 2, bh & 3, 63 - s, lam, lam_init, IN(17) + l * 64, wid);
                    }
                }
                GSYNC();
                {
                    pg8::Gemm g = pg8::make_gemm(Yb, Wl + OW_O, NTOK, DM, DM, DM, DM);
                    pg8::StaticOrder S; S.init(NTOK, DM, G, bx);
                    pg8::EpiRes<false> E{XN, IN(23) + l * DM, 1.0f, RSTD, nullptr, SLOTS, PCNT, xk};
                    pg8::gemm_phase<pg8::EpiRes<false>, pg8::StaticOrder, false, true>(lds, g, S, E, wid);
                    xk += 1;
                }
                GSYNC();
                {
                    pg8::Gemm g = pg8::make_gemm(XN, Wl + OW_Q, NTOK, DM, DM, DM, DM);
                    pg8::StaticOrder S; S.init(NTOK, DM, G, bx);
                    pg8::EpiOut E{BIG, DM, 0.09016844005556021f, RSTD, nullptr};
                    pg8::gemm_phase<pg8::EpiOut, pg8::StaticOrder, true, true>(lds, g, S, E, wid);
                }
                LSYNC();
                {
                    pg8::Gemm g = pg8::make_gemm(BIG, KX, NTOK, DM, 256, DM, DM);
                    g.a_pn = 256; g.b_pn = 256; g.b_pb = (long)256 * DM; g.bshift = 5;
                    pg8::StaticOrder S; S.init(NTOK, DM, G, bx);
                    pg8::EpiSoftmax E{BIG + (size_t)NTOK * DM, DM};
                    pg8::gemm_phase<pg8::EpiSoftmax, pg8::StaticOrder, false, true>(lds, g, S, E, wid);
                }
                LSYNC();
                {
                    pg8::Gemm g = pg8::make_gemm(BIG + (size_t)NTOK * DM, VXT, NTOK, DM, 256, DM, 512);
                    g.a_pn = 256; g.b_pn = (long)256 * 512; g.b_pb = 256; g.bshift = 5;
                    pg8::StaticOrder S; S.init(NTOK, DM, G, bx);
                    pg8::EpiOut E{BIG, DM, 1.0f, nullptr, nullptr};
                    pg8::gemm_phase<pg8::EpiOut, pg8::StaticOrder, true, true>(lds, g, S, E, wid);
                }
                GSYNC();
                {
                    pg8::Gemm g = pg8::make_gemm(BIG, Wl + OW_XO, NTOK, DM, DM, DM, DM);
                    pg8::StaticOrder S; S.init(NTOK, DM, G, bx);
                    pg8::EpiRes<false> E{XN, IN(30) + l * DM, 1.0f, RSTD, nullptr, SLOTS, PCNT, xk};
                    pg8::gemm_phase<pg8::EpiRes<false>, pg8::StaticOrder, false, true>(lds, g, S, E, wid);
                    xk += 1;
                }
                GSYNC();
            }
            {
                pg8::Gemm g = pg8::make_gemm(XN, Wl + (ff ? OW_GU2 : OW_GU1), NTOK, 2 * FF, DM, DM, DM);
                pg8::StaticOrder S; S.init(NTOK, 2 * FF, G, bx);
                pg8::EpiSwiGLU E{BIG, FF, RSTD};
                pg8::gemm_phase<pg8::EpiSwiGLU, pg8::StaticOrder, true, true>(lds, g, S, E, wid);
                if (bx >= 128 && !(l == 1 && ff == 1)) {
                    const int slot = (l == 0) ? (ff == 0 ? 1 : 3) : 4;
                    convert_slot(slot, (bx - 128) * 8 + wid, 128 * 8, ptab, Wb, lds, wid);
                }
            }
            GSYNC();
            {
                pg8::Gemm g = pg8::make_gemm(BIG, Wl + (ff ? OW_D2 : OW_D1), NTOK, DM, FF, FF, FF);
                pg8::StaticOrder S; S.init(NTOK, DM, G, bx);
                if (ff == 1 && l == 1) {
                    pg8::EpiRes<true> E{XN, IN(35) + l * DM, 0.5f, RSTD, p.out, SLOTS, PCNT, xk};
                    pg8::gemm_phase<pg8::EpiRes<true>, pg8::StaticOrder, false, true>(lds, g, S, E, wid);
                } else {
                    pg8::EpiRes<false> E{XN, IN(ff ? 35 : 7) + l * DM, 0.5f, RSTD, nullptr, SLOTS, PCNT, xk};
                    pg8::gemm_phase<pg8::EpiRes<false>, pg8::StaticOrder, false, true>(lds, g, S, E, wid);
                    xk += 1;
                }
            }
            if (!(ff == 1 && l == 1)) GSYNC();
        }
    }
}

extern "C" void kernel_launch(void* const* d_in, const int* in_sizes, int n_in, void* d_out, int out_size, void* d_ws, size_t ws_size, hipStream_t stream) {
    static int grid = 0;
    if (grid == 0) {
        if (n_in != 36 || out_size != NTOK * DM || ws_size < WS_END) { fprintf(stderr, "kernel_launch: unexpected problem (n_in %d out %d ws %zu)\n", n_in, out_size, ws_size); grid = -1; return; }
        int dev = 0, cus = 0, per_cu = 0;
        hipGetDevice(&dev);
        hipDeviceGetAttribute(&cus, hipDeviceAttributeMultiprocessorCount, dev);
        if (hipFuncSetAttribute((const void*)mega_fwd, hipFuncAttributeMaxDynamicSharedMemorySize, LDS_BYTES) != hipSuccess) { fprintf(stderr, "kernel_launch: hipFuncSetAttribute failed\n"); grid = -1; return; }
        hipOccupancyMaxActiveBlocksPerMultiprocessor(&per_cu, (const void*)mega_fwd, 512, LDS_BYTES);
        if (per_cu < 1) { fprintf(stderr, "kernel_launch: occupancy query says %d\n", per_cu); per_cu = 1; }
        (void)hipGetLastError();
        grid = cus;
        if (grid != 256) { fprintf(stderr, "kernel_launch: %d CUs (this kernel needs 256)\n", grid); grid = -1; return; }
    }
    if (grid < 0) return;
    Params p{};
    for (int i = 0; i < 36; ++i) p.in[i] = (const float*)d_in[i];
    p.out = (float*)d_out; p.ws = (unsigned char*)d_ws;
    void* args[] = {&p};
    hipError_t e = hipLaunchCooperativeKernel((const void*)mega_fwd, dim3(grid), dim3(512), args, LDS_BYTES, stream);
    if (e != hipSuccess) fprintf(stderr, "cooperative launch failed: %s (grid %d)\n", hipGetErrorString(e), grid);
}
```
